# Optimizing an MI355X kernel written in HIP

```python
import jax, jax.numpy as jnp
from jax import lax
import numpy as np

D_MODEL = 1024
BATCH = 8
SEQ = 4096
DEPTH = 2

HEAD_DIM = 64
ROPE_THETA = 10000.0
RMS_EPS = 1e-6
MIX_HALF = D_MODEL // 2
A_HEADS = MIX_HALF // HEAD_DIM
A_KV_HEADS = 2
IDX_HEADS = 8
IDX_DIM = 64
DSA_TOPK = 256
Q_BLOCK = 128
B_HEAD_DIM = 128
B_HEADS = MIX_HALF // B_HEAD_DIM
B_CHUNK = 64
C_WIDTH = MIX_HALF
C_BLOCKS = 8
C_BLOCK_W = C_WIDTH // C_BLOCKS
CONV_WIDTH = 4
RG_C = 8.0
D_HEADS = MIX_HALF // HEAD_DIM
D_KV_HEADS = 2
WINDOW = 128
MLP_HIDDEN = 4 * D_MODEL
N_EVEN = (DEPTH + 1) // 2
N_ODD = DEPTH // 2

EVEN_SPLITS = (A_HEADS * HEAD_DIM, A_KV_HEADS * HEAD_DIM, A_KV_HEADS * HEAD_DIM,
               IDX_HEADS * IDX_DIM, IDX_DIM, IDX_HEADS,
               MIX_HALF, MIX_HALF, MIX_HALF, MIX_HALF)
ODD_SPLITS = (C_WIDTH, C_WIDTH, D_HEADS * HEAD_DIM, D_KV_HEADS * HEAD_DIM, D_KV_HEADS * HEAD_DIM)

kernel_name = 'hybrid_dsa_hgrn2_rglru_swa_trunk'


def rms_norm(x, g):
    xf = x.astype(jnp.float32)
    y = xf * lax.rsqrt(jnp.mean(xf * xf, axis=-1, keepdims=True) + RMS_EPS)
    return (y * g.astype(jnp.float32)).astype(x.dtype)


def split_cols(z, sizes):
    cuts = [int(c) for c in np.cumsum(sizes)[:-1]]
    return jnp.split(z, cuts, axis=-1)


def rope_tables(positions, dim):
    inv_freq = 1.0 / (ROPE_THETA ** (jnp.arange(0, dim, 2, dtype=jnp.float32) / dim))
    ang = positions.astype(jnp.float32)[..., None] * inv_freq
    return jnp.cos(ang)[:, :, None, :], jnp.sin(ang)[:, :, None, :]


def apply_rope(x, cos, sin):
    xf = x.astype(jnp.float32)
    x1, x2 = jnp.split(xf, 2, axis=-1)
    return jnp.concatenate([x1 * cos - x2 * sin, x2 * cos + x1 * sin], axis=-1).astype(x.dtype)


def dsa_attention(q, k, v, iq, ik, iw):
    b, s, h, dh = q.shape
    hkv = k.shape[2]
    grp = h // hkv
    topk = min(DSA_TOPK, s // 4)
    nblk = s // Q_BLOCK
    key_pos = jnp.arange(s)

    def blocks(a):
        return a.reshape(b, nblk, Q_BLOCK, *a.shape[2:]).swapaxes(0, 1)

    def block_fn(args):
        qb, iqb, iwb, qpos = args
        sc = jnp.einsum('bqhd,bsd->bqhs', iqb, ik).astype(jnp.float32)
        score = jnp.einsum('bqhs,bqh->bqs', jax.nn.relu(sc) * IDX_DIM ** -0.5,
                           iwb.astype(jnp.float32) * IDX_HEADS ** -0.5)
        causal = key_pos[None, :] <= qpos[:, None]
        score = jnp.where(causal[None], score, -jnp.inf)
        _, sel = lax.top_k(score, topk)
        valid = sel <= qpos[None, :, None]
        ksel = jax.vmap(lambda kb, ib: kb[ib])(k, sel)
        vsel = jax.vmap(lambda vb, ib: vb[ib])(v, sel)
        qg = qb.reshape(b, Q_BLOCK, hkv, grp, dh)
        logits = jnp.einsum('bqgrd,bqkgd->bqgrk', qg, ksel).astype(jnp.float32) * dh ** -0.5
        logits = jnp.where(valid[:, :, None, None, :], logits, -jnp.inf)
        p = jax.nn.softmax(logits, axis=-1)
        o = jnp.einsum('bqgrk,bqkgd->bqgrd', p.astype(vsel.dtype), vsel)
        return o.reshape(b, Q_BLOCK, h * dh)

    qpos_blocks = jnp.arange(s).reshape(nblk, Q_BLOCK)
    out = lax.map(block_fn, (blocks(q), blocks(iq), blocks(iw), qpos_blocks))
    return out.swapaxes(0, 1).reshape(b, s, h * dh)


def hgrn2(q, f_logit, i, lb):
    b, s, _ = q.shape
    nc = s // B_CHUNK
    qf = jax.nn.silu(q.astype(jnp.float32))
    f = lb + (1.0 - lb) * jax.nn.sigmoid(f_logit.astype(jnp.float32))
    kf = 1.0 - f
    logf = jnp.log(f)

    def chunks(a):
        return a.astype(jnp.float32).reshape(b, nc, B_CHUNK, B_HEADS, B_HEAD_DIM).transpose(1, 0, 3, 2, 4)

    qc, kc, vc = chunks(qf), chunks(kf), chunks(i)
    bc = jnp.cumsum(chunks(logf), axis=3)
    tri = jnp.tril(jnp.ones((B_CHUNK, B_CHUNK), dtype=bool))

    def step(state, xs):
        qt, kt, vt, bt = xs
        rel = jnp.where(tri[None, None, :, :, None],
                        bt[:, :, :, None, :] - bt[:, :, None, :, :], -jnp.inf)
        att = jnp.einsum('bhtd,bhsd,bhtsd->bhts', qt, kt, jnp.exp(rel))
        o = jnp.einsum('bhts,bhsv->bhtv', att, vt) + \
            jnp.einsum('bhtd,bhdv->bhtv', qt * jnp.exp(bt), state)
        b_last = bt[:, :, -1:, :]
        new_state = jnp.exp(b_last[:, :, 0, :])[..., None] * state + \
            jnp.einsum('bhsd,bhsv->bhdv', kt * jnp.exp(b_last - bt), vt)
        return new_state, o

    state0 = jnp.zeros((b, B_HEADS, B_HEAD_DIM, B_HEAD_DIM), jnp.float32)
    _, o = lax.scan(step, state0, (qc, kc, vc, bc))
    return o.transpose(1, 0, 3, 2, 4).reshape(b, s, B_HEADS, B_HEAD_DIM)


def causal_depthwise_conv(x, w, bias):
    y = lax.conv_general_dilated(x, w[:, None, :].astype(x.dtype), window_strides=(1,),
                                 padding=[(CONV_WIDTH - 1, 0)],
                                 dimension_numbers=('NWC', 'WIO', 'NWC'),
                                 feature_group_count=x.shape[-1])
    return y + bias.astype(x.dtype)


def rg_lru(x, wr, br, wi, bi, lam):
    b, s, c = x.shape
    xf = x.astype(jnp.float32)
    xb = xf.reshape(b, s, C_BLOCKS, C_BLOCK_W)
    r = jax.nn.sigmoid(jnp.einsum('bsnc,ncd->bsnd', xb, wr.astype(jnp.float32)).reshape(b, s, c)
                       + br.astype(jnp.float32))
    ig = jax.nn.sigmoid(jnp.einsum('bsnc,ncd->bsnd', xb, wi.astype(jnp.float32)).reshape(b, s, c)
                        + bi.astype(jnp.float32))
    log_a = -RG_C * r * jax.nn.softplus(-lam.astype(jnp.float32))
    a = jnp.exp(log_a)
    u = jnp.sqrt(-jnp.expm1(2.0 * log_a)) * (ig * xf)

    def combine(left, right):
        a1, b1 = left
        a2, b2 = right
        return a1 * a2, a2 * b1 + b2

    _, h = lax.associative_scan(combine, (a, u), axis=1)
    return h.astype(x.dtype)


def swa_with_sinks(q, k, v, sinks):
    b, s, h, dh = q.shape
    hkv = k.shape[2]
    grp = h // hkv
    nb = s // WINDOW
    qb = q.reshape(b, nb, WINDOW, hkv, grp, dh)

    def with_prev(a):
        ab = a.reshape(b, nb, WINDOW, hkv, dh)
        prev = jnp.concatenate([jnp.zeros_like(ab[:, :1]), ab[:, :-1]], axis=1)
        return jnp.concatenate([prev, ab], axis=2)

    kk, vv = with_prev(k), with_prev(v)
    logits = jnp.einsum('bnqgrd,bnkgd->bngrqk', qb, kk).astype(jnp.float32) * dh ** -0.5
    qi = jnp.arange(WINDOW)[:, None]
    kj = jnp.arange(2 * WINDOW)[None, :]
    diff = WINDOW + qi - kj
    band = (diff >= 0) & (diff < WINDOW)
    key_abs = jnp.arange(nb)[:, None, None] * WINDOW + kj[None] - WINDOW
    mask = band[None] & (key_abs >= 0)
    logits = jnp.where(mask[None, :, None, None], logits, -jnp.inf)
    sink = sinks.astype(jnp.float32).reshape(hkv, grp)[None, None, :, :, None, None]
    m = jnp.maximum(jnp.max(logits, axis=-1, keepdims=True), sink)
    p = jnp.exp(logits - m)
    p = p / (jnp.sum(p, axis=-1, keepdims=True) + jnp.exp(sink - m))
    o = jnp.einsum('bngrqk,bnkgd->bnqgrd', p.astype(vv.dtype), vv)
    return o.reshape(b, s, h * dh)


def setup_inputs(seed: int = 0) -> dict:
    key = jax.random.key(seed)
    ks = jax.random.split(key, 26)
    f32 = jnp.float32

    def nrm(k, shape, scale):
        return jax.random.normal(k, shape, f32) * scale

    x = jax.random.normal(ks[0], (BATCH, SEQ, D_MODEL), f32)
    offsets = jax.random.randint(ks[1], (BATCH, 1), 0, 2048, dtype=jnp.int32)
    positions = offsets + jnp.arange(SEQ, dtype=jnp.int32)[None, :]
    lam_target = jax.random.uniform(ks[17], (N_ODD, C_WIDTH), f32, minval=0.9, maxval=0.999)
    lam_base = lam_target ** (1.0 / RG_C)
    return {
        'x': x,
        'positions': positions,
        'norm_mix_g': 1.0 + nrm(ks[2], (DEPTH, D_MODEL), 0.05),
        'norm_mlp_g': 1.0 + nrm(ks[3], (DEPTH, D_MODEL), 0.05),
        'even_w_in': nrm(ks[4], (N_EVEN, D_MODEL, sum(EVEN_SPLITS)), D_MODEL ** -0.5),
        'even_w_out': nrm(ks[5], (N_EVEN, D_MODEL, D_MODEL), D_MODEL ** -0.5),
        'a_q_norm_g': 1.0 + nrm(ks[6], (N_EVEN, HEAD_DIM), 0.05),
        'a_k_norm_g': 1.0 + nrm(ks[7], (N_EVEN, HEAD_DIM), 0.05),
        'b_lb_logits': nrm(ks[8], (N_EVEN + 1, MIX_HALF), 0.5),
        'b_out_norm_g': 1.0 + nrm(ks[9], (N_EVEN, B_HEAD_DIM), 0.05),
        'odd_w_in': nrm(ks[10], (N_ODD, D_MODEL, sum(ODD_SPLITS)), D_MODEL ** -0.5),
        'odd_w_out': nrm(ks[11], (N_ODD, D_MODEL, D_MODEL), D_MODEL ** -0.5),
        'c_conv_w': nrm(ks[12], (N_ODD, CONV_WIDTH, C_WIDTH), CONV_WIDTH ** -0.5),
        'c_conv_b': nrm(ks[13], (N_ODD, C_WIDTH), 0.01),
        'c_rgate_w': nrm(ks[14], (N_ODD, C_BLOCKS, C_BLOCK_W, C_BLOCK_W), C_BLOCK_W ** -0.5),
        'c_rgate_b': nrm(ks[15], (N_ODD, C_WIDTH), 0.01),
        'c_igate_w': nrm(ks[16], (N_ODD, C_BLOCKS, C_BLOCK_W, C_BLOCK_W), C_BLOCK_W ** -0.5),
        'c_igate_b': nrm(ks[18], (N_ODD, C_WIDTH), 0.01),
        'c_lambda': jnp.log(lam_base) - jnp.log1p(-lam_base),
        'd_q_norm_g': 1.0 + nrm(ks[19], (N_ODD, HEAD_DIM), 0.05),
        'd_k_norm_g': 1.0 + nrm(ks[20], (N_ODD, HEAD_DIM), 0.05),
        'd_sinks': nrm(ks[21], (N_ODD, D_HEADS), 0.5),
        'mlp_w_up': nrm(ks[22], (DEPTH, D_MODEL, MLP_HIDDEN), D_MODEL ** -0.5),
        'mlp_w_down': nrm(ks[23], (DEPTH, MLP_HIDDEN, D_MODEL), MLP_HIDDEN ** -0.5),
    }


def reference(x, positions, norm_mix_g, norm_mlp_g, even_w_in, even_w_out, a_q_norm_g, a_k_norm_g,
              b_lb_logits, b_out_norm_g, odd_w_in, odd_w_out, c_conv_w, c_conv_b, c_rgate_w, c_rgate_b,
              c_igate_w, c_igate_b, c_lambda, d_q_norm_g, d_k_norm_g, d_sinks, mlp_w_up, mlp_w_down):
    b, s, _ = x.shape
    cos, sin = rope_tables(positions, HEAD_DIM)
    cos_i, sin_i = rope_tables(positions, IDX_DIM)
    lb_all = jnp.cumsum(jax.nn.softmax(b_lb_logits.astype(jnp.float32), axis=0), axis=0)

    for layer in range(DEPTH):
        h = rms_norm(x, norm_mix_g[layer])
        if layer % 2 == 0:
            j = layer // 2
            z = h @ even_w_in[j]
            aq, ak, av, iq, ik, iw, bq, bf, bi, bg = split_cols(z, EVEN_SPLITS)
            aq = apply_rope(rms_norm(aq.reshape(b, s, A_HEADS, HEAD_DIM), a_q_norm_g[j]), cos, sin)
            ak = apply_rope(rms_norm(ak.reshape(b, s, A_KV_HEADS, HEAD_DIM), a_k_norm_g[j]), cos, sin)
            av = av.reshape(b, s, A_KV_HEADS, HEAD_DIM)
            iq = apply_rope(iq.reshape(b, s, IDX_HEADS, IDX_DIM), cos_i, sin_i)
            ik = apply_rope(ik[:, :, None, :], cos_i, sin_i)[:, :, 0, :]
            o_a = dsa_attention(aq, ak, av, iq, ik, iw)
            o_b = rms_norm(hgrn2(bq, bf, bi, lb_all[j]), b_out_norm_g[j]).reshape(b, s, MIX_HALF)
            o_b = (o_b * jax.nn.silu(bg.astype(jnp.float32))).astype(x.dtype)
            mix = jnp.concatenate([o_a.astype(x.dtype), o_b], axis=-1) @ even_w_out[j]
        else:
            j = layer // 2
            z = h @ odd_w_in[j]
            cg, cx, dq, dk, dv = split_cols(z, ODD_SPLITS)
            xc = causal_depthwise_conv(cx, c_conv_w[j], c_conv_b[j])
            o_c = jax.nn.gelu(cg) * rg_lru(xc, c_rgate_w[j], c_rgate_b[j], c_igate_w[j], c_igate_b[j], c_lambda[j])
            dq = apply_rope(rms_norm(dq.reshape(b, s, D_HEADS, HEAD_DIM), d_q_norm_g[j]), cos, sin)
            dk = apply_rope(rms_norm(dk.reshape(b, s, D_KV_HEADS, HEAD_DIM), d_k_norm_g[j]), cos, sin)
            dv = dv.reshape(b, s, D_KV_HEADS, HEAD_DIM)
            o_d = swa_with_sinks(dq, dk, dv, d_sinks[j])
            mix = jnp.concatenate([o_c.astype(x.dtype), o_d.astype(x.dtype)], axis=-1) @ odd_w_out[j]
        x = x + mix
        h = rms_norm(x, norm_mlp_g[layer])
        x = x + jnp.square(jax.nn.relu(h @ mlp_w_up[layer])) @ mlp_w_down[layer]
    return x
```

```cpp
#include <hip/hip_runtime.h>
#include <hip/hip_cooperative_groups.h>
#include <stdint.h>
#include <stdio.h>
namespace cg = cooperative_groups;

typedef unsigned short u16;
typedef __attribute__((ext_vector_type(8))) short bf16x8;
typedef __attribute__((ext_vector_type(4))) short bf16x4;
typedef __attribute__((ext_vector_type(16))) float f32x16;
typedef __attribute__((ext_vector_type(4))) float f32x4;
typedef __attribute__((ext_vector_type(8))) float f32x8;

#ifndef PHASE_MASK
#define PHASE_MASK 0x7ff
#endif
#ifndef REPEAT_MASK
#define REPEAT_MASK 0
#endif
#ifndef DSA_REP_A
#define DSA_REP_A 0
#endif
#ifndef DSA_REP_B
#define DSA_REP_B 0
#endif
#ifndef DSA_REP_C
#define DSA_REP_C 0
#endif
#ifndef PROBE_SUB
#define PROBE_SUB 3
#endif
#ifndef PROBE_PHASE
#define PROBE_PHASE -1
#endif
#ifndef MULTI_LAUNCH
#define MULTI_LAUNCH 0
#endif

static constexpr int T_TOK = 32768;
static constexpr int SEQ = 4096;
static constexpr int DM = 1024;
static constexpr int N_IN0 = 3456;
static constexpr int N_IN1 = 1792;
static constexpr int NPHASE = 11;
static constexpr int SMEM_BYTES = 73728;

struct Params {
  const float* x; const int* pos; const float* norm_mix_g; const float* norm_mlp_g;
  const float* even_w_in; const float* even_w_out; const float* a_q_g; const float* a_k_g;
  const float* b_lb; const float* b_out_g; const float* odd_w_in; const float* odd_w_out;
  const float* c_conv_w; const float* c_conv_b; const float* c_rg_w; const float* c_rg_b;
  const float* c_ig_w; const float* c_ig_b; const float* c_lam; const float* d_q_g; const float* d_k_g;
  const float* d_sinks; const float* mlp_up; const float* mlp_dn;
  float* out; char* ws;
  u16 *wt_in0, *wt_out0, *wt_up0, *wt_dn0, *wt_in1, *wt_out1, *wt_up1, *wt_dn1;
  u16 *abuf, *mixin; float* ss; float2* rope; unsigned* ctr;
  u16 *aq, *kv0, *iq, *ik; float* iw; u16* bq; float* blf; u16 *bi, *bg;
  u16* hid;
  u16* cg; float* cx; u16 *dq, *dkv;
};

__device__ __forceinline__ u16 f2bf(float f) {
  unsigned u = __float_as_uint(f);
  u += 0x7fffu + ((u >> 16) & 1u);
  return (u16)(u >> 16);
}
__device__ __forceinline__ float bf2f(u16 h) { return __uint_as_float(((unsigned)h) << 16); }
__device__ __forceinline__ unsigned pack2(float a, float b) { return (unsigned)f2bf(a) | ((unsigned)f2bf(b) << 16); }
__device__ __forceinline__ float sigmoidf_(float v) { return 1.f / (1.f + __expf(-v)); }
__device__ __forceinline__ float siluf_(float v) { return v * sigmoidf_(v); }
__device__ __forceinline__ float gelu_tanh(float v) {
  float u = 0.7978845608028654f * (v + 0.044715f * v * v * v);
  float th = 1.f - 2.f / (1.f + __expf(2.f * u));
  return 0.5f * v * (1.f + th);
}

__device__ __forceinline__ void store64_bf16(u16* dst, const float* v) {
#pragma unroll
  for (int i = 0; i < 8; ++i) {
    uint4 q;
    q.x = pack2(v[i * 8 + 0], v[i * 8 + 1]); q.y = pack2(v[i * 8 + 2], v[i * 8 + 3]);
    q.z = pack2(v[i * 8 + 4], v[i * 8 + 5]); q.w = pack2(v[i * 8 + 6], v[i * 8 + 7]);
    *(uint4*)(dst + i * 8) = q;
  }
}
__device__ __forceinline__ void store64_f32(float* dst, const float* v) {
#pragma unroll
  for (int i = 0; i < 16; ++i) *(float4*)(dst + i * 4) = make_float4(v[i * 4], v[i * 4 + 1], v[i * 4 + 2], v[i * 4 + 3]);
}
__device__ __forceinline__ void head_norm_rope(float* v, const float* g, const float2* rp, bool donorm, float scale) {
  if (donorm) {
    float ss = 0.f;
#pragma unroll
    for (int d = 0; d < 64; ++d) ss += v[d] * v[d];
    float r = rsqrtf(ss * (1.f / 64.f) + 1e-6f);
#pragma unroll
    for (int c = 0; c < 4; ++c) {
#pragma unroll
      for (int d = c * 16; d < c * 16 + 16; ++d) v[d] = v[d] * r * g[d];
      __builtin_amdgcn_sched_barrier(0);
    }
  }
#pragma unroll
  for (int c = 0; c < 4; ++c) {
#pragma unroll
    for (int d = c * 8; d < c * 8 + 8; ++d) {
      float2 cs = rp[d];
      float x1 = v[d], x2 = v[d + 32];
      v[d] = (x1 * cs.x - x2 * cs.y) * scale;
      v[d + 32] = (x2 * cs.x + x1 * cs.y) * scale;
    }
    __builtin_amdgcn_sched_barrier(0);
  }
}

__device__ __forceinline__ int next_item(unsigned* ctr, int* s_item) {
  __syncthreads();
  if (threadIdx.x == 0) *s_item = (int)atomicAdd(ctr, 1u);
  __syncthreads();
  return *s_item;
}

__device__ void prep_phase(const Params& p, char* smem) {
  const int tid = threadIdx.x;
  float* tile = (float*)smem;
  const int NT = 5920;
  const int NR = T_TOK / 4;
  for (int item = blockIdx.x; item < NT + NR; item += gridDim.x) {
    if (item < NT) {
      const float* src; u16* dst; int K, Nsrc, Ndst, base; int mode = 0;
      if (item < 864) { src = p.even_w_in; dst = p.wt_in0; K = 1024; Nsrc = 3400; Ndst = 3456; base = 0; mode = 1; }
      else if (item < 1120) { src = p.even_w_out; dst = p.wt_out0; K = 1024; Nsrc = 1024; Ndst = 1024; base = 864; }
      else if (item < 2144) { src = p.mlp_up; dst = p.wt_up0; K = 1024; Nsrc = 4096; Ndst = 4096; base = 1120; }
      else if (item < 3168) { src = p.mlp_dn; dst = p.wt_dn0; K = 4096; Nsrc = 1024; Ndst = 1024; base = 2144; }
      else if (item < 3616) { src = p.odd_w_in; dst = p.wt_in1; K = 1024; Nsrc = 1792; Ndst = 1792; base = 3168; }
      else if (item < 3872) { src = p.odd_w_out; dst = p.wt_out1; K = 1024; Nsrc = 1024; Ndst = 1024; base = 3616; }
      else if (item < 4896) { src = p.mlp_up + (size_t)1024 * 4096; dst = p.wt_up1; K = 1024; Nsrc = 4096; Ndst = 4096; base = 3872; }
      else { src = p.mlp_dn + (size_t)1024 * 4096; dst = p.wt_dn1; K = 4096; Nsrc = 1024; Ndst = 1024; base = 4896; }
      int li = item - base;
      int nk = K / 64;
      int n0 = (li / nk) * 64, k0 = (li % nk) * 64;
      __syncthreads();
#pragma unroll 4
      for (int i = 0; i < 16; ++i) {
        int k = i * 4 + (tid >> 6), n = tid & 63;
        int nd = n0 + n;
        int ns = nd;
        if (mode == 1) { ns = (nd < 1352) ? nd : ((nd < 1408) ? -1 : nd - 56); }
        float v = (ns >= 0) ? src[(size_t)(k0 + k) * Nsrc + ns] : 0.f;
        tile[k * 65 + n] = v;
      }
      __syncthreads();
#pragma unroll 4
      for (int i = 0; i < 8; ++i) {
        int n = i * 8 + (tid >> 5), k = (tid & 31) * 2;
        unsigned w = pack2(tile[k * 65 + n], tile[(k + 1) * 65 + n]);
        *(unsigned*)(dst + (size_t)(n0 + n) * K + k0 + k) = w;
      }
    } else {
      int rb = item - NT;
      if (rb == 0 && tid < 32) p.ctr[tid] = 0u;
      int t = rb * 4 + (tid >> 6);
      int lane = tid & 63;
      float ss = 0.f;
#pragma unroll
      for (int i = 0; i < 4; ++i) {
        int col = i * 256 + lane * 4;
        float4 xv = *(const float4*)(p.x + (size_t)t * DM + col);
        float4 gv = *(const float4*)(p.norm_mix_g + col);
        ss += xv.x * xv.x + xv.y * xv.y + xv.z * xv.z + xv.w * xv.w;
        uint2 w; w.x = pack2(xv.x * gv.x, xv.y * gv.y); w.y = pack2(xv.z * gv.z, xv.w * gv.w);
        *(uint2*)(p.abuf + (size_t)t * DM + col) = w;
      }
#pragma unroll
      for (int o = 32; o > 0; o >>= 1) ss += __shfl_xor(ss, o);
      if (lane == 0) {
        p.ss[t] = ss; p.ss[T_TOK + t] = 0.f; p.ss[2 * T_TOK + t] = 0.f; p.ss[3 * T_TOK + t] = 0.f;
      }
      if (lane < 32) {
        float invf = 1.0f / powf(10000.0f, (float)(2 * lane) / 64.0f);
        float ang = (float)p.pos[t] * invf;
        float s, c; sincosf(ang, &s, &c);
        p.rope[(size_t)t * 32 + lane] = make_float2(c, s);
      }
    }
  }
}

enum { EPI_IN0 = 0, EPI_RES = 1, EPI_UP = 2, EPI_IN1 = 3 };

struct GemmArgs {
  const u16* A; const u16* BT; int K; int ntn;
  const float* ssin;
  const float* xold; float* xnew; const float* gnext; float* ssout; u16* anext;
};

__device__ __forceinline__ void epi_rope(const float* rowp, float rstd, const float* g, const float2* rp, float scale, u16* dst) {
  float rn = rstd;
  if (g) {
    float ss = 0.f;
#pragma unroll 8
    for (int d = 0; d < 64; ++d) { float x = rowp[d] * rstd; ss += x * x; }
    rn = rstd * rsqrtf(ss * (1.f / 64.f) + 1e-6f);
  }
#pragma unroll
  for (int c = 0; c < 4; ++c) {
    f32x8 o1, o2;
#pragma unroll
    for (int e = 0; e < 8; ++e) {
      int d = c * 8 + e;
      float x1 = rowp[d] * rn, x2 = rowp[d + 32] * rn;
      if (g) { x1 *= g[d]; x2 *= g[d + 32]; }
      float2 cs = rp[d];
      o1[e] = (x1 * cs.x - x2 * cs.y) * scale;
      o2[e] = (x2 * cs.x + x1 * cs.y) * scale;
    }
    *(uint4*)(dst + c * 8) = make_uint4(pack2(o1[0], o1[1]), pack2(o1[2], o1[3]), pack2(o1[4], o1[5]), pack2(o1[6], o1[7]));
    *(uint4*)(dst + 32 + c * 8) = make_uint4(pack2(o2[0], o2[1]), pack2(o2[2], o2[3]), pack2(o2[4], o2[5]), pack2(o2[6], o2[7]));
    __builtin_amdgcn_sched_barrier(0);
  }
}
enum { F_ID = 0, F_SILU = 1, F_GELU = 2, F_RELU2 = 3 };
template <int F>
__device__ __forceinline__ float epi_fn(float x) {
  if (F == F_SILU) return siluf_(x);
  if (F == F_GELU) return gelu_tanh(x);
  if (F == F_RELU2) { float a = fmaxf(x, 0.f); return a * a; }
  return x;
}
template <int F>
__device__ __forceinline__ void epi_ew_bf16(const float* rowp, float rstd, u16* dst) {
#pragma unroll
  for (int c = 0; c < 4; ++c) {
    float o[16];
#pragma unroll
    for (int e = 0; e < 16; ++e) o[e] = epi_fn<F>(rowp[c * 16 + e] * rstd);
    *(uint4*)(dst + c * 16) = make_uint4(pack2(o[0], o[1]), pack2(o[2], o[3]), pack2(o[4], o[5]), pack2(o[6], o[7]));
    *(uint4*)(dst + c * 16 + 8) = make_uint4(pack2(o[8], o[9]), pack2(o[10], o[11]), pack2(o[12], o[13]), pack2(o[14], o[15]));
    __builtin_amdgcn_sched_barrier(0);
  }
}
__device__ __forceinline__ void epi_ew_f32(const float* rowp, float rstd, float* dst) {
#pragma unroll
  for (int c = 0; c < 4; ++c) {
#pragma unroll
    for (int e = 0; e < 4; ++e) {
      int d = c * 16 + e * 4;
      *(float4*)(dst + d) = make_float4(rowp[d] * rstd, rowp[d + 1] * rstd, rowp[d + 2] * rstd, rowp[d + 3] * rstd);
    }
    __builtin_amdgcn_sched_barrier(0);
  }
}

template <int EPI>
__device__ void gemm_epilogue(const Params& p, const GemmArgs& ga, const float* sC, int m0, int n0) {
  const int tid = threadIdx.x;
  const int r = tid >> 1, seg = tid & 1;
  const int t = m0 + r;
  const int gc = n0 + seg * 64;
  const float* rowp = sC + r * 129 + seg * 64;
  if (EPI == EPI_UP) {
    const int chunk = tid & 15, r16 = tid >> 4;
#pragma unroll
    for (int ps = 0; ps < 8; ++ps) {
      const int row = ps * 16 + r16;
      const int tt = m0 + row;
      const float rs = rsqrtf(ga.ssin[tt] * (1.f / 1024.f) + 1e-6f);
      const float* src = sC + row * 129 + chunk * 8;
      float o[8];
#pragma unroll
      for (int j = 0; j < 8; ++j) { float a = fmaxf(src[j] * rs, 0.f); o[j] = a * a; }
      *(uint4*)(p.hid + (size_t)tt * 4096 + n0 + chunk * 8) = make_uint4(pack2(o[0], o[1]), pack2(o[2], o[3]), pack2(o[4], o[5]), pack2(o[6], o[7]));
    }
    return;
  }
  if (EPI == EPI_RES) {
    const int c4 = tid & 31, r8 = tid >> 5;
    const int col = n0 + c4 * 4;
    float g0 = 0.f, g1 = 0.f, g2 = 0.f, g3 = 0.f;
    if (ga.gnext) { float4 gv = *(const float4*)(ga.gnext + col); g0 = gv.x; g1 = gv.y; g2 = gv.z; g3 = gv.w; }
#pragma unroll 4
    for (int ps = 0; ps < 16; ++ps) {
      const int row = ps * 8 + r8;
      const int tt = m0 + row;
      const float* src = sC + row * 129 + c4 * 4;
      float4 xv = *(const float4*)(ga.xold + (size_t)tt * DM + col);
      float o0 = xv.x + src[0], o1 = xv.y + src[1], o2 = xv.z + src[2], o3 = xv.w + src[3];
      *(float4*)(ga.xnew + (size_t)tt * DM + col) = make_float4(o0, o1, o2, o3);
      if (ga.gnext) {
        float ss = o0 * o0 + o1 * o1 + o2 * o2 + o3 * o3;
        *(uint2*)(ga.anext + (size_t)tt * DM + col) = make_uint2(pack2(o0 * g0, o1 * g1), pack2(o2 * g2, o3 * g3));
        ss += __shfl_xor(ss, 1); ss += __shfl_xor(ss, 2); ss += __shfl_xor(ss, 4); ss += __shfl_xor(ss, 8); ss += __shfl_xor(ss, 16);
        if (c4 == 0) atomicAdd(ga.ssout + tt, ss);
      }
    }
    return;
  }
  if (EPI == EPI_IN0 || EPI == EPI_IN1) {
    int fn = -1, ld = 0, cb = 0; u16* dstb = nullptr; float* dstf = nullptr;
    if (EPI == EPI_IN0) {
      if (n0 == 640) { fn = F_ID; dstb = p.kv0 + 128; ld = 256; cb = 640; }
      else if (n0 >= 1408 && n0 < 1920) { fn = F_SILU; dstb = p.bq; ld = 512; cb = 1408; }
      else if (n0 >= 1920 && n0 < 2432) { fn = 10; dstf = p.blf; ld = 512; cb = 1920; }
      else if (n0 >= 2432 && n0 < 2944) { fn = F_ID; dstb = p.bi; ld = 512; cb = 2432; }
      else if (n0 >= 2944) { fn = F_SILU; dstb = p.bg; ld = 512; cb = 2944; }
    } else {
      if (n0 < 512) { fn = F_GELU; dstb = p.cg; ld = 512; cb = 0; }
      else if (n0 < 1024) { fn = 11; dstf = p.cx; ld = 512; cb = 512; }
      else if (n0 == 1664) { fn = F_ID; dstb = p.dkv + 128; ld = 256; cb = 1664; }
    }
    {
      int rk = 0, rld = 0, rcb = 0; float rscale = 1.f; const float* rg = nullptr; u16* rdst = nullptr;
      if (EPI == EPI_IN0) {
        if (n0 < 512) { rk = 1; rg = p.a_q_g; rscale = 0.125f; rdst = p.aq; rld = 512; rcb = 0; }
        else if (n0 == 512) { rk = 1; rg = p.a_k_g; rdst = p.kv0; rld = 256; rcb = 512; }
        else if (n0 >= 768 && n0 < 1280) { rk = 1; rdst = p.iq; rld = 512; rcb = 768; }
      } else {
        if (n0 >= 1024 && n0 < 1536) { rk = 1; rg = p.d_q_g; rscale = 0.125f; rdst = p.dq; rld = 512; rcb = 1024; }
        else if (n0 == 1536) { rk = 1; rg = p.d_k_g; rdst = p.dkv; rld = 256; rcb = 1536; }
      }
      if (rk) {
        const int c = tid & 15, r16 = tid >> 4;
        const int hh = c >> 3, cc = c & 7;
        const float sgn = (cc < 4) ? -1.f : 1.f;
        const int dd0 = (cc & 3) * 8;
#pragma unroll 1
        for (int ps = 0; ps < 8; ++ps) {
          const int row = ps * 16 + r16;
          const int tt = m0 + row;
          const float rs = rsqrtf(ga.ssin[tt] * (1.f / 1024.f) + 1e-6f);
          const float* sm = sC + row * 129 + hh * 64 + cc * 8;
          const float* sp = sC + row * 129 + hh * 64 + (cc ^ 4) * 8;
          f32x8 mine, part;
          float ssq = 0.f;
#pragma unroll
          for (int j = 0; j < 8; ++j) { mine[j] = sm[j] * rs; part[j] = sp[j] * rs; ssq += mine[j] * mine[j]; }
          if (rg) {
            ssq += __shfl_xor(ssq, 1); ssq += __shfl_xor(ssq, 2); ssq += __shfl_xor(ssq, 4);
            const float rn = rsqrtf(ssq * (1.f / 64.f) + 1e-6f);
#pragma unroll
            for (int j = 0; j < 8; ++j) { mine[j] *= rn * rg[cc * 8 + j]; part[j] *= rn * rg[(cc ^ 4) * 8 + j]; }
          }
          const float2* rp2 = p.rope + (size_t)tt * 32 + dd0;
          f32x8 o;
#pragma unroll
          for (int j = 0; j < 8; ++j) {
            float2 cs = rp2[j];
            o[j] = (mine[j] * cs.x + sgn * part[j] * cs.y) * rscale;
          }
          *(uint4*)(rdst + (size_t)tt * rld + (n0 - rcb) + c * 8) = make_uint4(pack2(o[0], o[1]), pack2(o[2], o[3]), pack2(o[4], o[5]), pack2(o[6], o[7]));
        }
        return;
      }
    }
    if (fn >= 0 && fn < 10) {
      const int chunk = tid & 15, r16 = tid >> 4;
#pragma unroll 2
      for (int ps = 0; ps < 8; ++ps) {
        const int row = ps * 16 + r16;
        const int tt = m0 + row;
        const float rs = rsqrtf(ga.ssin[tt] * (1.f / 1024.f) + 1e-6f);
        const float* src = sC + row * 129 + chunk * 8;
        float o[8];
#pragma unroll
        for (int j = 0; j < 8; ++j) {
          float x = src[j] * rs;
          o[j] = (fn == F_SILU) ? siluf_(x) : ((fn == F_GELU) ? gelu_tanh(x) : x);
        }
        *(uint4*)(dstb + (size_t)tt * ld + (n0 - cb) + chunk * 8) = make_uint4(pack2(o[0], o[1]), pack2(o[2], o[3]), pack2(o[4], o[5]), pack2(o[6], o[7]));
      }
      return;
    }
    if (fn >= 10) {
      const int c4 = tid & 31, r8 = tid >> 5;
      const int cc = (n0 - cb) + c4 * 4;
      float lb0 = 0.f, lb1 = 0.f, lb2 = 0.f, lb3 = 0.f;
      if (fn == 10) {
        lb0 = sigmoidf_(p.b_lb[cc] - p.b_lb[512 + cc]); lb1 = sigmoidf_(p.b_lb[cc + 1] - p.b_lb[512 + cc + 1]);
        lb2 = sigmoidf_(p.b_lb[cc + 2] - p.b_lb[512 + cc + 2]); lb3 = sigmoidf_(p.b_lb[cc + 3] - p.b_lb[512 + cc + 3]);
      }
#pragma unroll 2
      for (int ps = 0; ps < 16; ++ps) {
        const int row = ps * 8 + r8;
        const int tt = m0 + row;
        const float rs = rsqrtf(ga.ssin[tt] * (1.f / 1024.f) + 1e-6f);
        const float* src = sC + row * 129 + c4 * 4;
        float o0 = src[0] * rs, o1 = src[1] * rs, o2 = src[2] * rs, o3 = src[3] * rs;
        if (fn == 10) {
          o0 = __logf(lb0 + (1.f - lb0) * sigmoidf_(o0)); o1 = __logf(lb1 + (1.f - lb1) * sigmoidf_(o1));
          o2 = __logf(lb2 + (1.f - lb2) * sigmoidf_(o2)); o3 = __logf(lb3 + (1.f - lb3) * sigmoidf_(o3));
        }
        *(float4*)(dstf + (size_t)tt * ld + cc) = make_float4(o0, o1, o2, o3);
      }
      return;
    }
  }
  const float rstd = rsqrtf(ga.ssin[t] * (1.f / 1024.f) + 1e-6f);

  const float2* rp = p.rope + (size_t)t * 32;
  if (EPI == EPI_IN0) {
    if (gc >= 1280 && gc < 1344) epi_rope(rowp, rstd, nullptr, rp, 1.f, p.ik + (size_t)t * 64);
    else if (gc >= 1344 && gc < 1408) {
      *(float4*)(p.iw + (size_t)t * 8) = make_float4(rowp[0] * rstd, rowp[1] * rstd, rowp[2] * rstd, rowp[3] * rstd);
      *(float4*)(p.iw + (size_t)t * 8 + 4) = make_float4(rowp[4] * rstd, rowp[5] * rstd, rowp[6] * rstd, rowp[7] * rstd);
    }
  }
}

#define G_LOAD(P, kt_) { \
  P##a0 = *(const uint4*)(Ag + (size_t)(0) * K + (kt_) * 64);  P##a1 = *(const uint4*)(Ag + (size_t)(32) * K + (kt_) * 64); \
  P##a2 = *(const uint4*)(Ag + (size_t)(64) * K + (kt_) * 64); P##a3 = *(const uint4*)(Ag + (size_t)(96) * K + (kt_) * 64); \
  P##b0 = *(const uint4*)(Bg + (size_t)(0) * K + (kt_) * 64);  P##b1 = *(const uint4*)(Bg + (size_t)(32) * K + (kt_) * 64); \
  P##b2 = *(const uint4*)(Bg + (size_t)(64) * K + (kt_) * 64); P##b3 = *(const uint4*)(Bg + (size_t)(96) * K + (kt_) * 64); }
#define S_STORE(P, buf_) { \
  *(uint4*)(sAw + (buf_) * 128 * 72 + 0 * 72) = P##a0;  *(uint4*)(sAw + (buf_) * 128 * 72 + 32 * 72) = P##a1; \
  *(uint4*)(sAw + (buf_) * 128 * 72 + 64 * 72) = P##a2; *(uint4*)(sAw + (buf_) * 128 * 72 + 96 * 72) = P##a3; \
  *(uint4*)(sBw + (buf_) * 128 * 72 + 0 * 72) = P##b0;  *(uint4*)(sBw + (buf_) * 128 * 72 + 32 * 72) = P##b1; \
  *(uint4*)(sBw + (buf_) * 128 * 72 + 64 * 72) = P##b2; *(uint4*)(sBw + (buf_) * 128 * 72 + 96 * 72) = P##b3; }
__device__ __forceinline__ void mma_tile(f32x16& acc00, f32x16& acc01, f32x16& acc10, f32x16& acc11, const u16* sA, const u16* sB, int buf, int wm, int wn, int lr, int lh) {
  const u16* a_base = sA + buf * 128 * 72 + (wm * 64 + lr) * 72 + lh * 8;
  const u16* b_base = sB + buf * 128 * 72 + (wn * 64 + lr) * 72 + lh * 8;
#pragma unroll
  for (int ks = 0; ks < 4; ++ks) {
    bf16x8 a0 = *(const bf16x8*)(a_base + ks * 16);
    bf16x8 a1 = *(const bf16x8*)(a_base + 32 * 72 + ks * 16);
    bf16x8 b0 = *(const bf16x8*)(b_base + ks * 16);
    bf16x8 b1 = *(const bf16x8*)(b_base + 32 * 72 + ks * 16);
    acc00 = __builtin_amdgcn_mfma_f32_32x32x16_bf16(a0, b0, acc00, 0, 0, 0);
    acc01 = __builtin_amdgcn_mfma_f32_32x32x16_bf16(a0, b1, acc01, 0, 0, 0);
    acc10 = __builtin_amdgcn_mfma_f32_32x32x16_bf16(a1, b0, acc10, 0, 0, 0);
    acc11 = __builtin_amdgcn_mfma_f32_32x32x16_bf16(a1, b1, acc11, 0, 0, 0);
  }
}

template <int EPI>
__device__ void gemm_phase(const Params& p, const GemmArgs& ga, char* smem) {
  const int tid = threadIdx.x, lane = tid & 63, wave = __builtin_amdgcn_readfirstlane(tid >> 6);
  const int wm = wave >> 1, wn = wave & 1;
  const int lr = lane & 31, lh = lane >> 5;
  const int K = ga.K;
  const int nk = K / 64;
  u16* sA = (u16*)smem;
  u16* sB = (u16*)(smem + 2 * 128 * 72 * 2);
  float* sC = (float*)smem;
  const int xcd = blockIdx.x & 7, slot = blockIdx.x >> 3, nslot = gridDim.x >> 3;
  const int nlocal = 32 * ga.ntn;
  for (int lt = slot; lt < nlocal; lt += nslot) {
    const int pp = lt & 7, rest = lt >> 3;
    const int tn = rest % ga.ntn, pg = rest / ga.ntn;
    const int tm = (pg * 8 + pp) * 8 + xcd;
    const int m0 = tm * 128, n0 = tn * 128;
    const u16* Ap = ga.A + (size_t)m0 * K;
    const u16* Bp = ga.BT + (size_t)n0 * K;
    f32x16 acc00, acc01, acc10, acc11;
#pragma unroll
    for (int e = 0; e < 16; ++e) { acc00[e] = 0.f; acc01[e] = 0.f; acc10[e] = 0.f; acc11[e] = 0.f; }
    const int srow = tid >> 3, scol = (tid & 7) * 8;
    const u16* Ag = Ap + (size_t)srow * K + scol;
    const u16* Bg = Bp + (size_t)srow * K + scol;
    u16* sAw = sA + srow * 72 + scol;
    u16* sBw = sB + srow * 72 + scol;
    uint4 p0a0, p0a1, p0a2, p0a3, p0b0, p0b1, p0b2, p0b3, p1a0, p1a1, p1a2, p1a3, p1b0, p1b1, p1b2, p1b3;
    G_LOAD(p0, 0)
    G_LOAD(p1, 1)
    S_STORE(p0, 0)
    __syncthreads();
    for (int kt = 0; kt < nk; kt += 2) {
      if (kt + 2 < nk) G_LOAD(p0, kt + 2)
      __builtin_amdgcn_sched_barrier(0);
      mma_tile(acc00, acc01, acc10, acc11, sA, sB, 0, wm, wn, lr, lh);
      S_STORE(p1, 1)
      __syncthreads();
      if (kt + 3 < nk) G_LOAD(p1, kt + 3)
      __builtin_amdgcn_sched_barrier(0);
      mma_tile(acc00, acc01, acc10, acc11, sA, sB, 1, wm, wn, lr, lh);
      if (kt + 2 < nk) S_STORE(p0, 0)
      __syncthreads();
    }
    {
      float* cb = sC + (wm * 64 + 4 * lh) * 129 + wn * 64 + lr;
#pragma unroll
      for (int e = 0; e < 16; ++e) {
        cb[((e & 3) + 8 * (e >> 2)) * 129] = acc00[e];
        cb[((e & 3) + 8 * (e >> 2)) * 129 + 32] = acc01[e];
        cb[(32 + (e & 3) + 8 * (e >> 2)) * 129] = acc10[e];
        cb[(32 + (e & 3) + 8 * (e >> 2)) * 129 + 32] = acc11[e];
      }
    }
    __syncthreads();
    gemm_epilogue<EPI>(p, ga, sC, m0, n0);
    __syncthreads();
  }
}

__device__ void attend_wave(const u16* Qb, const u16* KV, size_t tokbase, int tq, const u16* sel, int first_key, int nsel,
                            const float* sinks, float* sP, u16* outp) {
  const int lane = threadIdx.x & 63;
  const int n = lane & 15, G = lane >> 4;
  bf16x8 bq[4];
#pragma unroll
  for (int ks = 0; ks < 4; ++ks) {
    int kdim = ks * 32 + 8 * G;
    int kg = kdim >> 6, d0 = kdim & 63;
    bf16x8 z = {0, 0, 0, 0, 0, 0, 0, 0};
    if (n < 8 && (n >> 2) == kg) z = *(const bf16x8*)(Qb + (tokbase + tq) * 512 + n * 64 + d0);
    bq[ks] = z;
  }
  const int ntile = (nsel + 15) >> 4;
  bf16x8 ka0, ka1, ka2, ka3, kb0, kb1, kb2, kb3, kc0, kc1, kc2, kc3, kd0, kd1, kd2, kd3;
  float mx = -INFINITY;
#define QK_GATHER(A0, A1, A2, A3, ti_) { int slot = (ti_) * 16 + n; slot = slot < nsel ? slot : nsel - 1; \
    int idx = (int)sel[slot]; const u16* kr = KV + (tokbase + idx) * 256 + 8 * G; \
    A0 = *(const bf16x8*)(kr); A1 = *(const bf16x8*)(kr + 32); A2 = *(const bf16x8*)(kr + 64); A3 = *(const bf16x8*)(kr + 96); }
#define QK_USE(A0, A1, A2, A3, ti_) { f32x4 c = {0.f, 0.f, 0.f, 0.f}; \
    c = __builtin_amdgcn_mfma_f32_16x16x32_bf16(A0, bq[0], c, 0, 0, 0); \
    c = __builtin_amdgcn_mfma_f32_16x16x32_bf16(A1, bq[1], c, 0, 0, 0); \
    c = __builtin_amdgcn_mfma_f32_16x16x32_bf16(A2, bq[2], c, 0, 0, 0); \
    c = __builtin_amdgcn_mfma_f32_16x16x32_bf16(A3, bq[3], c, 0, 0, 0); \
    mx = fmaxf(mx, fmaxf(fmaxf(c[0], c[1]), fmaxf(c[2], c[3]))); \
    if (n < 8) { float* dp = sP + ((ti_) * 16 + 4 * G) * 8 + n; dp[0] = c[0]; dp[8] = c[1]; dp[16] = c[2]; dp[24] = c[3]; } }
  QK_GATHER(ka0, ka1, ka2, ka3, 0)
  QK_GATHER(kb0, kb1, kb2, kb3, 1)
  QK_GATHER(kc0, kc1, kc2, kc3, 2)
  QK_GATHER(kd0, kd1, kd2, kd3, 3)
  for (int ti0 = 0; ti0 < ntile; ti0 += 4) {
    bf16x8 ca0 = ka0, ca1 = ka1, ca2 = ka2, ca3 = ka3, cb0 = kb0, cb1 = kb1, cb2 = kb2, cb3 = kb3;
    bf16x8 cc0 = kc0, cc1 = kc1, cc2 = kc2, cc3 = kc3, cd0 = kd0, cd1 = kd1, cd2 = kd2, cd3 = kd3;
    if (ti0 + 4 < ntile) {
      QK_GATHER(ka0, ka1, ka2, ka3, ti0 + 4)
      QK_GATHER(kb0, kb1, kb2, kb3, ti0 + 5)
      QK_GATHER(kc0, kc1, kc2, kc3, ti0 + 6)
      QK_GATHER(kd0, kd1, kd2, kd3, ti0 + 7)
    }
    QK_USE(ca0, ca1, ca2, ca3, ti0)
    if (ti0 + 1 < ntile) QK_USE(cb0, cb1, cb2, cb3, ti0 + 1)
    if (ti0 + 2 < ntile) QK_USE(cc0, cc1, cc2, cc3, ti0 + 2)
    if (ti0 + 3 < ntile) QK_USE(cd0, cd1, cd2, cd3, ti0 + 3)
  }
#undef QK_GATHER
#undef QK_USE
  __builtin_amdgcn_wave_barrier();
  const int hh = lane & 7, sg = lane >> 3;
  mx = fmaxf(mx, __shfl_xor(mx, 16));
  mx = fmaxf(mx, __shfl_xor(mx, 32));
  float m = __shfl(mx, hh);
  float sk = 0.f;
  if (sinks) { sk = sinks[hh]; m = fmaxf(m, sk); }
  float sum = 0.f;
  for (int sl_ = sg; sl_ < nsel; sl_ += 8) {
    float e = __expf(sP[sl_ * 8 + hh] - m);
    sP[sl_ * 8 + hh] = e; sum += e;
  }
  sum += __shfl_xor(sum, 8);
  sum += __shfl_xor(sum, 16);
  sum += __shfl_xor(sum, 32);
  if (sinks) sum += __expf(sk - m);
  const float inv = 1.f / sum;
  __builtin_amdgcn_wave_barrier();
  const int kq = lane >> 4, c = lane & 15;
  const int g = c >> 3;
  f32x8 o0 = {0.f, 0.f, 0.f, 0.f, 0.f, 0.f, 0.f, 0.f}, o1 = o0, o2 = o0, o3 = o0;
  const u16* vbase = KV + tokbase * 256 + 128 + 8 * c;
  const int ngrp = (nsel + 3) >> 2;
  uint4 vq0, vq1, vq2, vq3, vq4, vq5, vq6, vq7;
#define PV_GATHER(V, it_) { int s_ = (it_) * 4 + kq; s_ = s_ < nsel ? s_ : nsel - 1; \
    int idx = (int)sel[s_]; V = *(const uint4*)(vbase + (size_t)idx * 256); }
#define PV_USE(V, it_) { int s_ = (it_) * 4 + kq; bool valid = s_ < nsel; int sc_ = valid ? s_ : nsel - 1; \
    float4 pp = *(const float4*)(sP + sc_ * 8 + 4 * g); if (!valid) pp = make_float4(0.f, 0.f, 0.f, 0.f); \
    f32x8 ve; \
    ve[0] = __uint_as_float(V.x << 16); ve[1] = __uint_as_float(V.x & 0xffff0000u); \
    ve[2] = __uint_as_float(V.y << 16); ve[3] = __uint_as_float(V.y & 0xffff0000u); \
    ve[4] = __uint_as_float(V.z << 16); ve[5] = __uint_as_float(V.z & 0xffff0000u); \
    ve[6] = __uint_as_float(V.w << 16); ve[7] = __uint_as_float(V.w & 0xffff0000u); \
    o0 += pp.x * ve; o1 += pp.y * ve; o2 += pp.z * ve; o3 += pp.w * ve; }
  PV_GATHER(vq0, 0) PV_GATHER(vq1, 1) PV_GATHER(vq2, 2) PV_GATHER(vq3, 3)
  PV_GATHER(vq4, 4) PV_GATHER(vq5, 5) PV_GATHER(vq6, 6) PV_GATHER(vq7, 7)
  for (int it0 = 0; it0 < ngrp; it0 += 8) {
    uint4 c0 = vq0, c1 = vq1, c2 = vq2, c3 = vq3, c4 = vq4, c5 = vq5, c6 = vq6, c7 = vq7;
    if (it0 + 8 < ngrp) {
      PV_GATHER(vq0, it0 + 8) PV_GATHER(vq1, it0 + 9) PV_GATHER(vq2, it0 + 10) PV_GATHER(vq3, it0 + 11)
      PV_GATHER(vq4, it0 + 12) PV_GATHER(vq5, it0 + 13) PV_GATHER(vq6, it0 + 14) PV_GATHER(vq7, it0 + 15)
    }
    PV_USE(c0, it0) PV_USE(c1, it0 + 1) PV_USE(c2, it0 + 2) PV_USE(c3, it0 + 3)
    PV_USE(c4, it0 + 4) PV_USE(c5, it0 + 5) PV_USE(c6, it0 + 6) PV_USE(c7, it0 + 7)
  }
#undef PV_GATHER
#undef PV_USE
#pragma unroll
  for (int e = 0; e < 8; ++e) {
    float v;
    v = o0[e]; v += __shfl_xor(v, 16); v += __shfl_xor(v, 32); o0[e] = v;
    v = o1[e]; v += __shfl_xor(v, 16); v += __shfl_xor(v, 32); o1[e] = v;
    v = o2[e]; v += __shfl_xor(v, 16); v += __shfl_xor(v, 32); o2[e] = v;
    v = o3[e]; v += __shfl_xor(v, 16); v += __shfl_xor(v, 32); o3[e] = v;
  }
  float iv = __shfl(inv, 4 * g + kq);
  f32x8 r8 = o0;
  r8 = (kq == 1) ? o1 : r8;
  r8 = (kq == 2) ? o2 : r8;
  r8 = (kq == 3) ? o3 : r8;
  r8 *= iv;
  *(uint4*)(outp + (4 * g + kq) * 64 + ((8 * c) & 63)) = make_uint4(pack2(r8[0], r8[1]), pack2(r8[2], r8[3]), pack2(r8[4], r8[5]), pack2(r8[6], r8[7]));
}

__device__ __noinline__ void dsa_select_unused(int); __device__ __forceinline__ void dsa_select(const u16* sc, unsigned* hs, u16* sl, int n, int target, int lane) {
  const int niter = (n + 63) >> 6;
  unsigned prefix = 0u;
  int need = target;
  for (int pass = 0; pass < 2; ++pass) {
    hs[lane] = 0u; hs[lane + 64] = 0u; hs[lane + 128] = 0u; hs[lane + 192] = 0u;
    asm volatile("s_waitcnt lgkmcnt(0)" ::: "memory");
#pragma unroll 2
    for (int i = 0; i < niter; ++i) {
      int key = i * 64 + lane;
      unsigned v = sc[key];
      bool act = (key < n) && (pass == 0 || (v >> 8) == prefix);
      unsigned bin = pass == 0 ? (v >> 8) : (v & 255u);
      if (act) atomicAdd(&hs[bin], 1u);
    }
    asm volatile("s_waitcnt lgkmcnt(0)" ::: "memory");
    uint4 cv = *(const uint4*)(hs + 4 * lane);
    int c0 = cv.x, c1 = cv.y, c2 = cv.z, c3 = cv.w;
    int sl4 = c0 + c1 + c2 + c3;
    int incl = sl4;
#pragma unroll
    for (int o = 1; o < 64; o <<= 1) {
      int tv = __shfl_down(incl, o);
      if (lane + o < 64) incl += tv;
    }
    int excl = incl - sl4;
    bool mine = (excl < need) && (need <= incl);
    int bsel = 0, above = excl;
    if (mine) {
      if (above + c3 >= need) bsel = 3;
      else { above += c3; if (above + c2 >= need) bsel = 2; else { above += c2; if (above + c1 >= need) bsel = 1; else { above += c1; bsel = 0; } } }
    }
    unsigned long long bm = __ballot(mine);
    int src = __ffsll((long long)bm) - 1;
    int binfull = __shfl(4 * lane + bsel, src);
    int abovefull = __shfl(above, src);
    prefix = (pass == 0) ? (unsigned)binfull : ((prefix << 8) | (unsigned)binfull);
    need -= abovefull;
    asm volatile("s_waitcnt lgkmcnt(0)" ::: "memory");
  }
  const unsigned Tthr = prefix;
  const int cgt = target - need;
  int posg = 0, post = 0;
  const unsigned long long lt = (1ull << lane) - 1ull;
#pragma unroll 4
  for (int i = 0; i < niter; ++i) {
    int key = i * 64 + lane;
    unsigned v = sc[key];
    bool inr = key < n;
    bool isg = inr && (v > Tthr);
    bool ist = inr && (v == Tthr);
    unsigned long long bg = __ballot(isg), bt = __ballot(ist);
    int rg = posg + __popcll(bg & lt);
    int rt = post + __popcll(bt & lt);
    if (isg) sl[rg] = (u16)key;
    if (ist && rt < need) sl[cgt + rt] = (u16)key;
    posg += __popcll(bg); post += __popcll(bt);
  }
}

__device__ void dsa_item(const Params& p, int b, int q0, char* smem, int sub) {
  u16* score16 = (u16*)smem;
  unsigned* hist = (unsigned*)(smem + 65536);
  u16* selL = (u16*)(smem + 65536 + 4096);
  const int tid = threadIdx.x, lane = tid & 63, wave = __builtin_amdgcn_readfirstlane(tid >> 6);
  const int lr = lane & 31, lh = lane >> 5;
  const size_t tokbase = (size_t)b * SEQ;
  const int nkeys = q0 + 8;
  const int ntile = (nkeys + 31) >> 5;
  if (!(sub & 4)) {
    const int m = lr;
    const int i_ = m >> 3, gg = (m >> 2) & 1, j_ = m & 3;
    const int qq = 2 * gg + (i_ >> 1), hh = (i_ & 1) * 4 + j_;
    const u16* ap0 = p.iq + (tokbase + q0 + qq) * 512 + hh * 64 + lh * 8;
    const u16* ap1 = ap0 + 4 * 512;
    bf16x8 a00 = *(const bf16x8*)(ap0), a01 = *(const bf16x8*)(ap0 + 16), a02 = *(const bf16x8*)(ap0 + 32), a03 = *(const bf16x8*)(ap0 + 48);
    bf16x8 a10 = *(const bf16x8*)(ap1), a11 = *(const bf16x8*)(ap1 + 16), a12 = *(const bf16x8*)(ap1 + 32), a13 = *(const bf16x8*)(ap1 + 48);
    f32x16 w0, w1;
#pragma unroll
    for (int r = 0; r < 16; ++r) {
      w0[r] = p.iw[(tokbase + q0 + 2 * lh + (r >> 3)) * 8 + (r & 7)];
      w1[r] = p.iw[(tokbase + q0 + 4 + 2 * lh + (r >> 3)) * 8 + (r & 7)];
    }
    const u16* ikb = p.ik + tokbase * 64 + lr * 64 + lh * 8;
    bf16x8 n0, n1, n2, n3;
    if (wave < ntile) {
      const u16* bp = ikb + (size_t)wave * 32 * 64;
      n0 = *(const bf16x8*)(bp); n1 = *(const bf16x8*)(bp + 16); n2 = *(const bf16x8*)(bp + 32); n3 = *(const bf16x8*)(bp + 48);
    }
    for (int kt = wave; kt < ntile; kt += 4) {
      int key = kt * 32 + lr;
      bf16x8 b0 = n0, b1 = n1, b2 = n2, b3 = n3;
      if (kt + 4 < ntile) {
        const u16* bp = ikb + (size_t)(kt + 4) * 32 * 64;
        n0 = *(const bf16x8*)(bp); n1 = *(const bf16x8*)(bp + 16); n2 = *(const bf16x8*)(bp + 32); n3 = *(const bf16x8*)(bp + 48);
      }
      f32x16 c0, c1;
#pragma unroll
      for (int e = 0; e < 16; ++e) { c0[e] = 0.f; c1[e] = 0.f; }
      c0 = __builtin_amdgcn_mfma_f32_32x32x16_bf16(a00, b0, c0, 0, 0, 0);
      c1 = __builtin_amdgcn_mfma_f32_32x32x16_bf16(a10, b0, c1, 0, 0, 0);
      c0 = __builtin_amdgcn_mfma_f32_32x32x16_bf16(a01, b1, c0, 0, 0, 0);
      c1 = __builtin_amdgcn_mfma_f32_32x32x16_bf16(a11, b1, c1, 0, 0, 0);
      c0 = __builtin_amdgcn_mfma_f32_32x32x16_bf16(a02, b2, c0, 0, 0, 0);
      c1 = __builtin_amdgcn_mfma_f32_32x32x16_bf16(a12, b2, c1, 0, 0, 0);
      c0 = __builtin_amdgcn_mfma_f32_32x32x16_bf16(a03, b3, c0, 0, 0, 0);
      c1 = __builtin_amdgcn_mfma_f32_32x32x16_bf16(a13, b3, c1, 0, 0, 0);
      float s0 = 0.f, s1 = 0.f, s2 = 0.f, s3 = 0.f;
#pragma unroll
      for (int r = 0; r < 8; ++r) {
        s0 += fmaxf(c0[r], 0.f) * w0[r]; s1 += fmaxf(c0[8 + r], 0.f) * w0[8 + r];
        s2 += fmaxf(c1[r], 0.f) * w1[r]; s3 += fmaxf(c1[8 + r], 0.f) * w1[8 + r];
      }
      f32x4 sv = {s0, s1, s2, s3};
#pragma unroll
      for (int k = 0; k < 4; ++k) {
        float sf = sv[k] + 0.f;
        unsigned u = __float_as_uint(sf);
        unsigned ua = u & 0x7fffffffu;
        int mag = (int)(ua >> 13) - ((127 - 20) << 10);
        mag = mag < 0 ? 0 : (mag > 0x7fff ? 0x7fff : mag);
        unsigned k16 = (u & 0x80000000u) ? (unsigned)(0x7fff - mag) : (0x8000u | (unsigned)mag);
        k16 = k16 < 1u ? 1u : k16;
        int ql = (k >> 1) * 4 + 2 * lh + (k & 1);
        unsigned v16 = (key > q0 + ql) ? 0u : k16;
        score16[ql * 4096 + key] = (u16)v16;
      }
    }
  }
  __syncthreads();
#pragma unroll 1
  for (int rep = 0; rep < 2; ++rep) {
    const int ql = wave + 4 * rep;
    const int q = q0 + ql;
    const int n = q + 1;
    const int target = n < 256 ? n : 256;
    if (!(sub & 4)) dsa_select(score16 + ql * 4096, hist + wave * 256, selL + ql * 256, n, target, lane);
  }
  __syncthreads();
#pragma unroll 1
  for (int rep = 0; rep < 2; ++rep) {
    const int ql = wave + 4 * rep;
    const int q = q0 + ql;
    const int n = q + 1;
    const int target = n < 256 ? n : 256;
    if (!(sub & 8))
      attend_wave(p.aq, p.kv0, tokbase, q, selL + ql * 256, 0, target, nullptr, (float*)(score16 + wave * 4096), p.mixin + (tokbase + q) * 1024);
  }
}

__device__ void hgrn_item(const Params& p, int b, int h, char* smem) {
  u16* sQ = (u16*)smem;
  u16* sK = (u16*)(smem + 17408);
  u16* sKT = (u16*)(smem + 34816);
  u16* sVT = (u16*)(smem + 34816 + 18432);
  float* sDecay = (float*)(smem + 71680);
  float* sTot = (float*)(smem + 71680 + 512);
  float* sO = (float*)smem;
  const int tid = threadIdx.x, lane = tid & 63, wave = __builtin_amdgcn_readfirstlane(tid >> 6);
  const int lr = lane & 31, lh = lane >> 5;
  const size_t tokbase = (size_t)b * SEQ;
  f32x16 S[4];
#pragma unroll
  for (int i = 0; i < 4; ++i)
#pragma unroll
    for (int e = 0; e < 16; ++e) S[i][e] = 0.f;
  for (int c = 0; c < 64; ++c) {
    const int t0 = c * 64;
    __syncthreads();
    uint4 gv0, gv1, gv2, gv3;
    {
      const size_t tok0 = tokbase + t0;
      float* sLF = (float*)smem;
      u16* sQst = sKT;
      float4 l0, l1, l2, l3, l4, l5, l6, l7;
      {
        const int c4 = tid & 31, r0 = tid >> 5;
        const float* lp = p.blf + (tok0 + r0) * 512 + h * 128 + c4 * 4;
        l0 = *(const float4*)(lp); l1 = *(const float4*)(lp + 8 * 512); l2 = *(const float4*)(lp + 16 * 512);
        l3 = *(const float4*)(lp + 24 * 512); l4 = *(const float4*)(lp + 32 * 512); l5 = *(const float4*)(lp + 40 * 512);
        l6 = *(const float4*)(lp + 48 * 512); l7 = *(const float4*)(lp + 56 * 512);
      }
      uint4 q0, q1, q2, q3;
      {
        const int c8 = tid & 15, r0 = tid >> 4;
        const u16* qp = p.bq + (tok0 + r0) * 512 + h * 128 + c8 * 8;
        q0 = *(const uint4*)(qp); q1 = *(const uint4*)(qp + 16 * 512); q2 = *(const uint4*)(qp + 32 * 512); q3 = *(const uint4*)(qp + 48 * 512);
      }
      const int tt = tid >> 2, v0 = (tid & 3) * 32;
      const u16* vp = p.bi + (tok0 + tt) * 512 + h * 128 + v0;
      uint4 w0 = *(const uint4*)(vp), w1 = *(const uint4*)(vp + 8), w2 = *(const uint4*)(vp + 16), w3 = *(const uint4*)(vp + 24);
      const u16* gp = p.bg + (tok0 + tt) * 512 + h * 128 + v0;
      gv0 = *(const uint4*)(gp); gv1 = *(const uint4*)(gp + 8); gv2 = *(const uint4*)(gp + 16); gv3 = *(const uint4*)(gp + 24);
      {
        const int c4 = tid & 31, r0 = tid >> 5;
        float* sp = sLF + r0 * 128 + c4 * 4;
        *(float4*)(sp) = l0; *(float4*)(sp + 8 * 128) = l1; *(float4*)(sp + 16 * 128) = l2; *(float4*)(sp + 24 * 128) = l3;
        *(float4*)(sp + 32 * 128) = l4; *(float4*)(sp + 40 * 128) = l5; *(float4*)(sp + 48 * 128) = l6; *(float4*)(sp + 56 * 128) = l7;
        const int c8 = tid & 15, r1 = tid >> 4;
        u16* qs = sQst + r1 * 128 + c8 * 8;
        *(uint4*)(qs) = q0; *(uint4*)(qs + 16 * 128) = q1; *(uint4*)(qs + 32 * 128) = q2; *(uint4*)(qs + 48 * 128) = q3;
      }
      {
        u16* vt = sVT + v0 * 72 + tt;
#define VT_PUT(W, e_) { vt[(2 * (e_)) * 72] = (u16)((W) & 0xffffu); vt[(2 * (e_) + 1) * 72] = (u16)((W) >> 16); }
        VT_PUT(w0.x, 0) VT_PUT(w0.y, 1) VT_PUT(w0.z, 2) VT_PUT(w0.w, 3)
        VT_PUT(w1.x, 4) VT_PUT(w1.y, 5) VT_PUT(w1.z, 6) VT_PUT(w1.w, 7)
        VT_PUT(w2.x, 8) VT_PUT(w2.y, 9) VT_PUT(w2.z, 10) VT_PUT(w2.w, 11)
        VT_PUT(w3.x, 12) VT_PUT(w3.y, 13) VT_PUT(w3.z, 14) VT_PUT(w3.w, 15)
#undef VT_PUT
      }
      __syncthreads();
      const int d = tid & 127, half = tid >> 7;
      float lfr[32];
      unsigned short qr[32];
      float tot = 0.f;
#pragma unroll
      for (int i = 0; i < 32; ++i) {
        lfr[i] = sLF[(half * 32 + i) * 128 + d];
        qr[i] = sQst[(half * 32 + i) * 128 + d];
        tot += lfr[i];
      }
      sTot[half * 128 + d] = tot;
      __syncthreads();
      float t0v = sTot[d], t1v = sTot[128 + d];
      float blast = t0v + t1v;
      float run = half ? t0v : 0.f;
      if (half == 0) sDecay[d] = __expf(blast);
      u16* sQw = sQ + (half * 32) * 136 + d;
      u16* sKw = sK + (half * 32) * 136 + d;
      u16* sKTw = sKT + d * 72 + half * 32;
#pragma unroll
      for (int i = 0; i < 32; ++i) {
        float qvi = bf2f(qr[i]);
        float lfi = lfr[i];
        run += lfi;
        float bc = fmaxf(run, -80.f);
        float e = __expf(bc);
        float kf = 1.f - __expf(lfi);
        float qt = qvi * e;
        float kt = kf * __expf(-bc);
        sQw[i * 136] = f2bf(qt);
        u16 kb = f2bf(kt);
        sKw[i * 136] = kb;
        sKTw[i] = kb;
      }
    }
    __syncthreads();
    __builtin_amdgcn_sched_barrier(0);
    f32x16 X00, X01, X11;
#pragma unroll
    for (int e = 0; e < 16; ++e) { X00[e] = 0.f; X01[e] = 0.f; X11[e] = 0.f; }
#pragma unroll
    for (int ks = 0; ks < 8; ++ks) {
      bf16x8 k0 = *(const bf16x8*)(sK + (lr) * 136 + ks * 16 + lh * 8);
      bf16x8 k1 = *(const bf16x8*)(sK + (32 + lr) * 136 + ks * 16 + lh * 8);
      bf16x8 q0 = *(const bf16x8*)(sQ + (lr) * 136 + ks * 16 + lh * 8);
      bf16x8 q1 = *(const bf16x8*)(sQ + (32 + lr) * 136 + ks * 16 + lh * 8);
      X00 = __builtin_amdgcn_mfma_f32_32x32x16_bf16(k0, q0, X00, 0, 0, 0);
      X01 = __builtin_amdgcn_mfma_f32_32x32x16_bf16(k0, q1, X01, 0, 0, 0);
      X11 = __builtin_amdgcn_mfma_f32_32x32x16_bf16(k1, q1, X11, 0, 0, 0);
    }
    {
      const int dl = lr - 4 * lh;
#pragma unroll
      for (int e = 0; e < 16; ++e) {
        if (((e & 3) + 8 * (e >> 2)) > dl) { X00[e] = 0.f; X11[e] = 0.f; }
      }
    }
    __builtin_amdgcn_sched_barrier(0);
    f32x16 O0, O1;
#pragma unroll
    for (int e = 0; e < 16; ++e) { O0[e] = 0.f; O1[e] = 0.f; }
    const u16* vrow = sVT + (wave * 32 + lr) * 72;
#pragma unroll
    for (int s2 = 0; s2 < 2; ++s2) {
      bf16x8 a00, a01, a11;
#pragma unroll
      for (int j = 0; j < 8; ++j) {
        a00[j] = (short)f2bf(X00[8 * s2 + j]);
        a01[j] = (short)f2bf(X01[8 * s2 + j]);
        a11[j] = (short)f2bf(X11[8 * s2 + j]);
      }
      bf16x4 v0a = *(const bf16x4*)(vrow + 0 + 16 * s2 + 4 * lh);
      bf16x4 v0b = *(const bf16x4*)(vrow + 0 + 16 * s2 + 4 * lh + 8);
      bf16x4 v1a = *(const bf16x4*)(vrow + 32 + 16 * s2 + 4 * lh);
      bf16x4 v1b = *(const bf16x4*)(vrow + 32 + 16 * s2 + 4 * lh + 8);
      bf16x8 bv0 = {v0a[0], v0a[1], v0a[2], v0a[3], v0b[0], v0b[1], v0b[2], v0b[3]};
      bf16x8 bv1 = {v1a[0], v1a[1], v1a[2], v1a[3], v1b[0], v1b[1], v1b[2], v1b[3]};
      O0 = __builtin_amdgcn_mfma_f32_32x32x16_bf16(a00, bv0, O0, 0, 0, 0);
      O1 = __builtin_amdgcn_mfma_f32_32x32x16_bf16(a01, bv0, O1, 0, 0, 0);
      O1 = __builtin_amdgcn_mfma_f32_32x32x16_bf16(a11, bv1, O1, 0, 0, 0);
    }
    __builtin_amdgcn_sched_barrier(0);
#ifndef HG_NO_P2
#pragma unroll
    for (int db = 0; db < 4; ++db) {
#pragma unroll
      for (int s2 = 0; s2 < 2; ++s2) {
        bf16x8 bs;
#pragma unroll
        for (int j = 0; j < 8; ++j) bs[j] = (short)f2bf(S[db][8 * s2 + j]);
        const u16* q0p = sQ + (lr) * 136 + db * 32 + 16 * s2 + 4 * lh;
        const u16* q1p = sQ + (32 + lr) * 136 + db * 32 + 16 * s2 + 4 * lh;
        bf16x4 x0a = *(const bf16x4*)(q0p), x0b = *(const bf16x4*)(q0p + 8);
        bf16x4 x1a = *(const bf16x4*)(q1p), x1b = *(const bf16x4*)(q1p + 8);
        bf16x8 aq0 = {x0a[0], x0a[1], x0a[2], x0a[3], x0b[0], x0b[1], x0b[2], x0b[3]};
        bf16x8 aq1 = {x1a[0], x1a[1], x1a[2], x1a[3], x1b[0], x1b[1], x1b[2], x1b[3]};
        O0 = __builtin_amdgcn_mfma_f32_32x32x16_bf16(aq0, bs, O0, 0, 0, 0);
        O1 = __builtin_amdgcn_mfma_f32_32x32x16_bf16(aq1, bs, O1, 0, 0, 0);
      }
      __builtin_amdgcn_sched_barrier(0);
    }
#endif
    __builtin_amdgcn_sched_barrier(0);
#ifndef HG_NO_SU
#pragma unroll
    for (int db = 0; db < 4; ++db) {
#pragma unroll
      for (int ks = 0; ks < 4; ++ks) {
        bf16x8 ak = *(const bf16x8*)(sKT + (db * 32 + lr) * 72 + ks * 16 + lh * 8);
        bf16x8 bv = *(const bf16x8*)(vrow + ks * 16 + lh * 8);
        S[db] = __builtin_amdgcn_mfma_f32_32x32x16_bf16(ak, bv, S[db], 0, 0, 0);
      }
      {
        const float* dcp = sDecay + 4 * lh;
#pragma unroll
        for (int e = 0; e < 16; ++e) S[db][e] *= dcp[db * 32 + (e & 3) + 8 * (e >> 2)];
      }
      __builtin_amdgcn_sched_barrier(0);
    }
#endif
    __syncthreads();
    {
      float* ob = sO + (4 * lh) * 132 + wave * 32 + lr;
#pragma unroll
      for (int e = 0; e < 16; ++e) {
        ob[((e & 3) + 8 * (e >> 2)) * 132] = O0[e];
        ob[(32 + (e & 3) + 8 * (e >> 2)) * 132] = O1[e];
      }
    }
    __syncthreads();
#ifndef HG_NO_NORM
    {
      int tt = tid >> 2, qd = tid & 3;
      float ov[32];
      float ss = 0.f;
#pragma unroll
      for (int i = 0; i < 32; ++i) { ov[i] = sO[tt * 132 + qd * 32 + i]; ss += ov[i] * ov[i]; }
      ss += __shfl_xor(ss, 1);
      ss += __shfl_xor(ss, 2);
      float r = rsqrtf(ss * (1.f / 128.f) + 1e-6f);
      size_t tok = tokbase + t0 + tt;
      u16* op = p.mixin + tok * 1024 + 512 + h * 128 + qd * 32;
      const float* bog = p.b_out_g + qd * 32;
#define HG_OUT(GW, i_) { \
        const int vi = (i_) * 8; \
        unsigned o0_ = pack2(ov[vi + 0] * r * bog[vi + 0] * __uint_as_float(GW.x << 16), ov[vi + 1] * r * bog[vi + 1] * __uint_as_float(GW.x & 0xffff0000u)); \
        unsigned o1_ = pack2(ov[vi + 2] * r * bog[vi + 2] * __uint_as_float(GW.y << 16), ov[vi + 3] * r * bog[vi + 3] * __uint_as_float(GW.y & 0xffff0000u)); \
        unsigned o2_ = pack2(ov[vi + 4] * r * bog[vi + 4] * __uint_as_float(GW.z << 16), ov[vi + 5] * r * bog[vi + 5] * __uint_as_float(GW.z & 0xffff0000u)); \
        unsigned o3_ = pack2(ov[vi + 6] * r * bog[vi + 6] * __uint_as_float(GW.w << 16), ov[vi + 7] * r * bog[vi + 7] * __uint_as_float(GW.w & 0xffff0000u)); \
        *(uint4*)(op + vi) = make_uint4(o0_, o1_, o2_, o3_); }
      HG_OUT(gv0, 0) HG_OUT(gv1, 1) HG_OUT(gv2, 2) HG_OUT(gv3, 3)
#undef HG_OUT
    }
#endif
  }
}

__device__ void mixer0_phase(const Params& p, char* smem, int coff, int sub) {
  int* s_item = (int*)(smem + SMEM_BYTES - 16);
#ifndef NO_HGRN
#ifndef REPEAT_HGRN
#define REPEAT_HGRN 0
#endif
  if (sub & 1)
  for (;;) {
    int item = next_item(p.ctr + coff + 0, s_item);
    if (item >= 32) break;
    hgrn_item(p, item >> 2, item & 3, smem);
  }
#endif
#ifndef NO_DSA
#ifndef REPEAT_DSA
#define REPEAT_DSA 0
#endif
  if (sub & 2) {
    const int b = blockIdx.x & 7;
    int di = next_item(p.ctr + coff + 8 + b, s_item);
    while (di < 512) {
      unsigned nxt = 0u;
      if (threadIdx.x == 0) nxt = atomicAdd(p.ctr + coff + 8 + b, 1u);
      dsa_item(p, b, (511 - di) * 8, smem, sub);
      __syncthreads();
      if (threadIdx.x == 0) *s_item = (int)nxt;
      __syncthreads();
      di = *s_item;
    }
  }
#endif
}

__device__ __forceinline__ void swa_item(const Params& p, int b, int g, int qblk, char* smem) {
  u16* sVT = (u16*)smem;
  const int tid = threadIdx.x, lane = tid & 63, wave = __builtin_amdgcn_readfirstlane(tid >> 6);
  const int lr = lane & 31, lh = lane >> 5;
  const size_t tokbase = (size_t)b * SEQ;
  const int t0 = qblk * 32, kbase = t0 - 128;
  const int h = 4 * g + wave;
  __syncthreads();
#pragma unroll
  for (int i = 0; i < 5; ++i) {
    int cidx = tid + 256 * i;
    int key = cidx >> 3, dc = (cidx & 7) * 8;
    int j = kbase + key; j = j < 0 ? 0 : j;
    uint4 w = *(const uint4*)(p.dkv + (tokbase + j) * 256 + 128 + g * 64 + dc);
    unsigned ww[4] = {w.x, w.y, w.z, w.w};
    u16* dst = sVT + dc * 168 + key;
#pragma unroll
    for (int e = 0; e < 4; ++e) {
      dst[(2 * e) * 168] = (u16)(ww[e] & 0xffffu);
      dst[(2 * e + 1) * 168] = (u16)(ww[e] >> 16);
    }
  }
  bf16x8 qf[4];
  {
    const u16* qp = p.dq + (tokbase + t0 + lr) * 512 + h * 64 + 8 * lh;
#pragma unroll
    for (int ks = 0; ks < 4; ++ks) qf[ks] = *(const bf16x8*)(qp + ks * 16);
  }
  f32x16 S0, S1, S2, S3, S4;
#define SWA_QK(ST, kt_) { \
    int j = kbase + (kt_) * 32 + lr; j = j < 0 ? 0 : j; \
    const u16* kp = p.dkv + (tokbase + j) * 256 + g * 64 + 8 * lh; \
    bf16x8 k0 = *(const bf16x8*)(kp), k1 = *(const bf16x8*)(kp + 16), k2 = *(const bf16x8*)(kp + 32), k3 = *(const bf16x8*)(kp + 48); \
    _Pragma("unroll") for (int e = 0; e < 16; ++e) ST[e] = 0.f; \
    ST = __builtin_amdgcn_mfma_f32_32x32x16_bf16(k0, qf[0], ST, 0, 0, 0); \
    ST = __builtin_amdgcn_mfma_f32_32x32x16_bf16(k1, qf[1], ST, 0, 0, 0); \
    ST = __builtin_amdgcn_mfma_f32_32x32x16_bf16(k2, qf[2], ST, 0, 0, 0); \
    ST = __builtin_amdgcn_mfma_f32_32x32x16_bf16(k3, qf[3], ST, 0, 0, 0); }
  SWA_QK(S0, 0) SWA_QK(S1, 1) SWA_QK(S2, 2) SWA_QK(S3, 3) SWA_QK(S4, 4)
#undef SWA_QK
  const int tq = t0 + lr;
  float m = -INFINITY;
#define SWA_MASK(ST, kt_) { _Pragma("unroll") for (int e = 0; e < 16; ++e) { \
    int j = kbase + (kt_) * 32 + (e & 3) + 8 * (e >> 2) + 4 * lh; \
    bool ok = (j >= 0) && (j <= tq) && (j > tq - 128); \
    float v = ok ? ST[e] : -INFINITY; ST[e] = v; m = fmaxf(m, v); } }
  SWA_MASK(S0, 0) SWA_MASK(S1, 1) SWA_MASK(S2, 2) SWA_MASK(S3, 3) SWA_MASK(S4, 4)
#undef SWA_MASK
  m = fmaxf(m, __shfl_xor(m, 32));
  const float sk = p.d_sinks[h];
  m = fmaxf(m, sk);
  float sum = 0.f;
#define SWA_EXP(ST) { _Pragma("unroll") for (int e = 0; e < 16; ++e) { float pv = __expf(ST[e] - m); ST[e] = pv; sum += pv; } }
  SWA_EXP(S0) SWA_EXP(S1) SWA_EXP(S2) SWA_EXP(S3) SWA_EXP(S4)
#undef SWA_EXP
  sum += __shfl_xor(sum, 32);
  sum += __expf(sk - m);
  const float inv = 1.f / sum;
  __syncthreads();
  f32x16 O0, O1;
#pragma unroll
  for (int e = 0; e < 16; ++e) { O0[e] = 0.f; O1[e] = 0.f; }
#define SWA_PV(ST, kt_) { _Pragma("unroll") for (int s2 = 0; s2 < 2; ++s2) { \
    bf16x8 pb; \
    _Pragma("unroll") for (int j = 0; j < 8; ++j) pb[j] = (short)f2bf(ST[8 * s2 + j]); \
    const u16* v0p = sVT + lr * 168 + (kt_) * 32 + 16 * s2 + 4 * lh; \
    const u16* v1p = v0p + 32 * 168; \
    bf16x4 a0a = *(const bf16x4*)(v0p), a0b = *(const bf16x4*)(v0p + 8); \
    bf16x4 a1a = *(const bf16x4*)(v1p), a1b = *(const bf16x4*)(v1p + 8); \
    bf16x8 va0 = {a0a[0], a0a[1], a0a[2], a0a[3], a0b[0], a0b[1], a0b[2], a0b[3]}; \
    bf16x8 va1 = {a1a[0], a1a[1], a1a[2], a1a[3], a1b[0], a1b[1], a1b[2], a1b[3]}; \
    O0 = __builtin_amdgcn_mfma_f32_32x32x16_bf16(va0, pb, O0, 0, 0, 0); \
    O1 = __builtin_amdgcn_mfma_f32_32x32x16_bf16(va1, pb, O1, 0, 0, 0); } }
  SWA_PV(S0, 0) SWA_PV(S1, 1) SWA_PV(S2, 2) SWA_PV(S3, 3) SWA_PV(S4, 4)
#undef SWA_PV
  u16* op = p.mixin + (tokbase + tq) * 1024 + 512 + h * 64 + 4 * lh;
#pragma unroll
  for (int i = 0; i < 4; ++i) {
    *(uint2*)(op + 8 * i) = make_uint2(pack2(O0[4 * i] * inv, O0[4 * i + 1] * inv), pack2(O0[4 * i + 2] * inv, O0[4 * i + 3] * inv));
    *(uint2*)(op + 32 + 8 * i) = make_uint2(pack2(O1[4 * i] * inv, O1[4 * i + 1] * inv), pack2(O1[4 * i + 2] * inv, O1[4 * i + 3] * inv));
  }
}

__device__ void griffin_item(const Params& p, int b, int nb, int qq, char* smem) {
  float* sWr = (float*)smem;
  float* sWi = sWr + 1040;
  float* sCW = sWi + 1040;
  float* sCB = sCW + 256;
  float* sCst = sCB + 64;
  float* sAa = sCst + 48;
  float* sUu = sAa + 64 * 17;
  float* sSumA = sUu + 64 * 17;
  float* sSumH = sSumA + 256;
  float* sCarry = sSumH + 256;
  float* sG = sCarry + 16;
  float* sXo = sG + 64 * 33;
  u16* sXb = (u16*)(sXo + 64 * 17 + 4);
  const int tid = threadIdx.x, lane = tid & 63;
  const int wave = __builtin_amdgcn_readfirstlane(tid >> 6);
  const int lr = lane & 31, lh = lane >> 5;
  const int cgp = tid & 3, tl = tid >> 2;
  const size_t tokbase = (size_t)b * SEQ;
  const int cbase = nb * 64;
  const int obase = cbase + qq * 16;
  __syncthreads();
  sCW[tid] = p.c_conv_w[(tid >> 6) * 512 + cbase + (tid & 63)];
  if (tid < 64) sCB[tid] = p.c_conv_b[cbase + tid];
  if (tid < 16) {
    sCarry[tid] = 0.f;
    sCst[tid] = p.c_rg_b[obase + tid]; sCst[16 + tid] = p.c_ig_b[obase + tid];
    sCst[32 + tid] = log1pf(__expf(-p.c_lam[obase + tid]));
  }
  __syncthreads();
  u16* sWb = sXb + 64 * 72;
  {
    const int col = tid >> 3, ci0 = (tid & 7) * 8;
    const float* wsrc = ((col < 16) ? (p.c_rg_w + qq * 16 + col) : (p.c_ig_w + qq * 16 + (col - 16))) + (size_t)nb * 4096 + ci0 * 64;
    float w8[8];
#pragma unroll
    for (int j = 0; j < 8; ++j) w8[j] = wsrc[j * 64];
    *(uint4*)(sWb + col * 72 + ci0) = make_uint4(pack2(w8[0], w8[1]), pack2(w8[2], w8[3]), pack2(w8[4], w8[5]), pack2(w8[6], w8[7]));
  }
  __syncthreads();
  const int c = tid & 15, seg = tid >> 4;
  const float* cxp = p.cx + tokbase * 512 + cbase + cgp * 16;
  float4 nx[16];
#pragma unroll
  for (int i = 0; i < 16; ++i) nx[i] = make_float4(0.f, 0.f, 0.f, 0.f);
  for (int tile = -1; tile < 64; ++tile) {
    u16 ccg[4];
    if (tile >= 0) {
      int sg0 = seg, c0_ = c;
      asm volatile("" : "+v"(sg0), "+v"(c0_));
      const u16* cgt0 = p.cg + (tokbase + tile * 64 + sg0 * 4) * 512 + obase + c0_;
#pragma unroll
      for (int i = 0; i < 4; ++i) ccg[i] = cgt0[i * 512];
    } else {
#pragma unroll
      for (int i = 0; i < 4; ++i) ccg[i] = 0;
    }
    f32x16 xc;
#pragma unroll
    for (int j = 0; j < 4; ++j) {
      float4 acc4 = *(const float4*)(sCB + cgp * 16 + j * 4);
#pragma unroll
      for (int w = 0; w < 4; ++w) {
        float4 wv = *(const float4*)(sCW + w * 64 + cgp * 16 + j * 4);
        float4 xv = nx[w * 4 + j];
        acc4.x += xv.x * wv.x; acc4.y += xv.y * wv.y; acc4.z += xv.z * wv.z; acc4.w += xv.w * wv.w;
      }
      xc[j * 4] = acc4.x; xc[j * 4 + 1] = acc4.y; xc[j * 4 + 2] = acc4.z; xc[j * 4 + 3] = acc4.w;
    }
    __builtin_amdgcn_sched_barrier(0);
    if (tile + 1 < 64) {
      int tlo = tl, sgo = seg;
      asm volatile("" : "+v"(tlo), "+v"(sgo));
      const float* cpt = cxp + (size_t)((tile + 1) * 64 + tlo - 3) * 512;
      const bool first = (tile + 1 == 0);
#pragma unroll
      for (int w = 0; w < 4; ++w) {
        const bool ok = !first || (tlo - 3 + w >= 0);
#pragma unroll
        for (int j = 0; j < 4; ++j) nx[w * 4 + j] = ok ? *(const float4*)(cpt + w * 512 + j * 4) : make_float4(0.f, 0.f, 0.f, 0.f);
      }

    }
    __builtin_amdgcn_sched_barrier(0);
    if (tile < 0) continue;
    int tlv = tl, cgv = cgp;
    asm volatile("" : "+v"(tlv), "+v"(cgv));
    {
      u16* xb = sXb + tlv * 72 + cgv * 16;
      *(uint4*)(xb) = make_uint4(pack2(xc[0], xc[1]), pack2(xc[2], xc[3]), pack2(xc[4], xc[5]), pack2(xc[6], xc[7]));
      *(uint4*)(xb + 8) = make_uint4(pack2(xc[8], xc[9]), pack2(xc[10], xc[11]), pack2(xc[12], xc[13]), pack2(xc[14], xc[15]));
      if (cgp == qq) {
#pragma unroll
        for (int k = 0; k < 16; ++k) sXo[tlv * 17 + k] = xc[k];
      }
    }
    asm volatile("s_waitcnt lgkmcnt(0)" ::: "memory");
    {
      const int l15 = lane & 15, l4 = lane >> 4;
      const u16* ab = sXb + (wave * 16 + l15) * 72 + 8 * l4;
      const u16* wb = sWb + l15 * 72 + 8 * l4;
      f32x4 g0 = {0.f, 0.f, 0.f, 0.f}, g1 = {0.f, 0.f, 0.f, 0.f};
#pragma unroll
      for (int ks = 0; ks < 2; ++ks) {
        bf16x8 a = *(const bf16x8*)(ab + ks * 32);
        bf16x8 b0 = *(const bf16x8*)(wb + ks * 32);
        bf16x8 b1 = *(const bf16x8*)(wb + 16 * 72 + ks * 32);
        g0 = __builtin_amdgcn_mfma_f32_16x16x32_bf16(a, b0, g0, 0, 0, 0);
        g1 = __builtin_amdgcn_mfma_f32_16x16x32_bf16(a, b1, g1, 0, 0, 0);
      }
      float* gb = sG + (wave * 16 + 4 * l4) * 33 + l15;
#pragma unroll
      for (int j = 0; j < 4; ++j) { gb[j * 33] = g0[j]; gb[j * 33 + 16] = g1[j]; }
    }
    asm volatile("s_waitcnt lgkmcnt(0)" ::: "memory");
#pragma unroll
    for (int k = 0; k < 4; ++k) {
      int cc = cgv * 4 + k;
      float rp = sG[tlv * 33 + cc] + sCst[cc];
      float ip = sG[tlv * 33 + 16 + cc] + sCst[16 + cc];
      float r = __builtin_amdgcn_rcpf(1.f + __expf(-rp));
      float ig = __builtin_amdgcn_rcpf(1.f + __expf(-ip));
      float la = -8.f * r * sCst[32 + cc];
      float a = __expf(la);
      float u = __builtin_amdgcn_sqrtf(fmaxf(1.f - a * a, 0.f)) * (ig * sXo[tlv * 17 + cc]);
      sAa[tlv * 17 + cc] = a;
      sUu[tlv * 17 + cc] = u;
    }
    __syncthreads();
    float av[4], uv[4];
    {
      float A = 1.f, H = 0.f;
#pragma unroll
      for (int i = 0; i < 4; ++i) {
        av[i] = sAa[(seg * 4 + i) * 17 + c]; uv[i] = sUu[(seg * 4 + i) * 17 + c];
        H = av[i] * H + uv[i]; A *= av[i];
      }
      sSumA[seg * 16 + c] = A; sSumH[seg * 16 + c] = H;
    }
    __syncthreads();
    float hcur = sCarry[c];
    for (int s2 = 0; s2 < seg; ++s2) hcur = sSumA[s2 * 16 + c] * hcur + sSumH[s2 * 16 + c];
    __syncthreads();
    {
      int sg2 = seg, c2 = c;
      asm volatile("" : "+v"(sg2), "+v"(c2));
      u16* mo = p.mixin + (tokbase + tile * 64 + sg2 * 4) * 1024 + obase + c2;
#pragma unroll
      for (int i = 0; i < 4; ++i) {
        hcur = av[i] * hcur + uv[i];
        mo[i * 1024] = f2bf(bf2f(ccg[i]) * hcur);
      }
    }
    if (seg == 15) sCarry[c] = hcur;
  }
}

__device__ void mixer1_phase(const Params& p, char* smem, int coff, int sub) {
  int* s_item = (int*)(smem + SMEM_BYTES - 16);
  const int wave = __builtin_amdgcn_readfirstlane(threadIdx.x >> 6);
#ifndef NO_GRIFFIN
  if (sub & 1)
  for (;;) {
    int item = next_item(p.ctr + coff + 1, s_item);
    if (item >= 256) break;
    griffin_item(p, item >> 5, (item >> 2) & 7, item & 3, smem);
  }
#endif
#ifndef NO_SWA
  if (sub & 2) {
    const int b = blockIdx.x & 7;
    const size_t tokbase = (size_t)b * SEQ;
    int si = next_item(p.ctr + coff + 16 + b, s_item);
    while (si < 256) {
      unsigned nxt = 0u;
      if (threadIdx.x == 0) nxt = atomicAdd(p.ctr + coff + 16 + b, 1u);
      swa_item(p, b, si & 1, si >> 1, smem);
      __syncthreads();
      if (threadIdx.x == 0) *s_item = (int)nxt;
      __syncthreads();
      si = *s_item;
    }
  }
#endif
}

__device__ __forceinline__ void carve_ws(Params& p) {
  char* w = p.ws;
  size_t off = 0;
  auto take = [&](size_t bytes) { char* r = w + off; off += (bytes + 255) & ~(size_t)255; return r; };
  p.wt_in0 = (u16*)take((size_t)N_IN0 * 1024 * 2);
  p.wt_out0 = (u16*)take((size_t)1024 * 1024 * 2);
  p.wt_up0 = (u16*)take((size_t)4096 * 1024 * 2);
  p.wt_dn0 = (u16*)take((size_t)4096 * 1024 * 2);
  p.wt_in1 = (u16*)take((size_t)N_IN1 * 1024 * 2);
  p.wt_out1 = (u16*)take((size_t)1024 * 1024 * 2);
  p.wt_up1 = (u16*)take((size_t)4096 * 1024 * 2);
  p.wt_dn1 = (u16*)take((size_t)4096 * 1024 * 2);
  p.abuf = (u16*)take((size_t)T_TOK * 1024 * 2);
  p.mixin = (u16*)take((size_t)T_TOK * 1024 * 2);
  p.ss = (float*)take((size_t)4 * T_TOK * 4);
  p.rope = (float2*)take((size_t)T_TOK * 32 * 8);
  p.ctr = (unsigned*)take(256);
  char* big = take((size_t)T_TOK * 4096 * 2);
  p.hid = (u16*)big;
  {
    size_t o2 = 0;
    auto take2 = [&](size_t bytes) { char* r = big + o2; o2 += (bytes + 255) & ~(size_t)255; return r; };
    p.aq = (u16*)take2((size_t)T_TOK * 512 * 2);
    p.kv0 = (u16*)take2((size_t)T_TOK * 256 * 2);
    p.iq = (u16*)take2((size_t)T_TOK * 512 * 2);
    p.ik = (u16*)take2((size_t)T_TOK * 64 * 2);
    p.iw = (float*)take2((size_t)T_TOK * 8 * 4);
    p.bq = (u16*)take2((size_t)T_TOK * 512 * 2);
    p.blf = (float*)take2((size_t)T_TOK * 512 * 4);
    p.bi = (u16*)take2((size_t)T_TOK * 512 * 2);
    p.bg = (u16*)take2((size_t)T_TOK * 512 * 2);
  }
  {
    size_t o2 = 0;
    auto take2 = [&](size_t bytes) { char* r = big + o2; o2 += (bytes + 255) & ~(size_t)255; return r; };
    p.cg = (u16*)take2((size_t)T_TOK * 512 * 2);
    p.cx = (float*)take2((size_t)T_TOK * 512 * 4);
    p.dq = (u16*)take2((size_t)T_TOK * 512 * 2);
    p.dkv = (u16*)take2((size_t)T_TOK * 256 * 2);
  }
}

__global__ void __launch_bounds__(256, 2) mega_kernel(Params pin, int ph_lo, int ph_hi, int sub) {
  Params p = pin;
  carve_ws(p);
  __shared__ __attribute__((aligned(16))) char smem[SMEM_BYTES];
  GemmArgs ga;
#define PHASE_BEGIN(n) if (((PHASE_MASK >> n) & 1) && ph_lo <= n && n <= ph_hi) { if (n > ph_lo) cg::this_grid().sync();
#define PHASE_END }
  PHASE_BEGIN(0) for (int rep = 0; rep < 1 + (REPEAT_MASK & 1); ++rep) { if (rep) cg::this_grid().sync(); prep_phase(p, smem); } PHASE_END
  PHASE_BEGIN(1)
    ga = GemmArgs{p.abuf, p.wt_in0, 1024, N_IN0 / 128, p.ss, nullptr, nullptr, nullptr, nullptr, nullptr};
    for (int rep = 0; rep < 1 + ((REPEAT_MASK >> 1) & 1); ++rep) { if (rep) cg::this_grid().sync(); gemm_phase<EPI_IN0>(p, ga, smem); }
  PHASE_END
  PHASE_BEGIN(2) for (int rep = 0; rep < 1 + ((REPEAT_MASK >> 2) & 1); ++rep) { if (rep) cg::this_grid().sync(); mixer0_phase(p, smem, rep * 4, sub); } PHASE_END
  PHASE_BEGIN(3)
    ga = GemmArgs{p.mixin, p.wt_out0, 1024, 8, nullptr, p.x, p.out, p.norm_mlp_g, p.ss + T_TOK, p.abuf};
    gemm_phase<EPI_RES>(p, ga, smem);
  PHASE_END
  PHASE_BEGIN(4)
    ga = GemmArgs{p.abuf, p.wt_up0, 1024, 32, p.ss + T_TOK, nullptr, nullptr, nullptr, nullptr, nullptr};
    for (int rep = 0; rep < 1 + ((REPEAT_MASK >> 4) & 1); ++rep) { if (rep) cg::this_grid().sync(); gemm_phase<EPI_UP>(p, ga, smem); }
  PHASE_END
  PHASE_BEGIN(5)
    ga = GemmArgs{p.hid, p.wt_dn0, 4096, 8, nullptr, p.out, p.out, p.norm_mix_g + 1024, p.ss + 2 * T_TOK, p.abuf};
    gemm_phase<EPI_RES>(p, ga, smem);
  PHASE_END
  PHASE_BEGIN(6)
    ga = GemmArgs{p.abuf, p.wt_in1, 1024, N_IN1 / 128, p.ss + 2 * T_TOK, nullptr, nullptr, nullptr, nullptr, nullptr};
    gemm_phase<EPI_IN1>(p, ga, smem);
  PHASE_END
  PHASE_BEGIN(7) for (int rep = 0; rep < 1 + ((REPEAT_MASK >> 7) & 1); ++rep) { if (rep) cg::this_grid().sync(); mixer1_phase(p, smem, rep * 4, sub); } PHASE_END
  PHASE_BEGIN(8)
    ga = GemmArgs{p.mixin, p.wt_out1, 1024, 8, nullptr, p.out, p.out, p.norm_mlp_g + 1024, p.ss + 3 * T_TOK, p.abuf};
    gemm_phase<EPI_RES>(p, ga, smem);
  PHASE_END
  PHASE_BEGIN(9)
    ga = GemmArgs{p.abuf, p.wt_up1, 1024, 32, p.ss + 3 * T_TOK, nullptr, nullptr, nullptr, nullptr, nullptr};
    gemm_phase<EPI_UP>(p, ga, smem);
  PHASE_END
  PHASE_BEGIN(10)
    ga = GemmArgs{p.hid, p.wt_dn1, 4096, 8, nullptr, p.out, p.out, nullptr, nullptr, nullptr};
    gemm_phase<EPI_RES>(p, ga, smem);
  PHASE_END
}

extern "C" void kernel_launch(void* const* d_in, const int* in_sizes, int n_in, void* d_out, int out_size, void* d_ws,
                              size_t ws_size, hipStream_t stream) {
  Params p{};
  p.x = (const float*)d_in[0]; p.pos = (const int*)d_in[1];
  p.norm_mix_g = (const float*)d_in[2]; p.norm_mlp_g = (const float*)d_in[3];
  p.even_w_in = (const float*)d_in[4]; p.even_w_out = (const float*)d_in[5];
  p.a_q_g = (const float*)d_in[6]; p.a_k_g = (const float*)d_in[7];
  p.b_lb = (const float*)d_in[8]; p.b_out_g = (const float*)d_in[9];
  p.odd_w_in = (const float*)d_in[10]; p.odd_w_out = (const float*)d_in[11];
  p.c_conv_w = (const float*)d_in[12]; p.c_conv_b = (const float*)d_in[13];
  p.c_rg_w = (const float*)d_in[14]; p.c_rg_b = (const float*)d_in[15];
  p.c_ig_w = (const float*)d_in[16]; p.c_ig_b = (const float*)d_in[17];
  p.c_lam = (const float*)d_in[18]; p.d_q_g = (const float*)d_in[19]; p.d_k_g = (const float*)d_in[20];
  p.d_sinks = (const float*)d_in[21]; p.mlp_up = (const float*)d_in[22]; p.mlp_dn = (const float*)d_in[23];
  p.out = (float*)d_out;
  p.ws = (char*)d_ws;
  static int grid_blocks = 0;
  if (!grid_blocks) {
    int dev = 0, cus = 0, per_cu = 0;
    hipGetDevice(&dev);
    hipDeviceGetAttribute(&cus, hipDeviceAttributeMultiprocessorCount, dev);
    hipOccupancyMaxActiveBlocksPerMultiprocessor(&per_cu, mega_kernel, 256, 0);
    if (per_cu < 1) per_cu = 1;
    if (per_cu > 2) per_cu = 2;
    grid_blocks = cus * per_cu;
  }
#if MULTI_LAUNCH
  for (int ph = 0; ph < NPHASE; ++ph) {
    hipLaunchKernelGGL(mega_kernel, dim3(grid_blocks), dim3(256), 0, stream, p, ph, ph, 3);
  }
#else
  int lo = 0, hi = NPHASE - 1, sub3 = 3;
  void* args[] = {&p, &lo, &hi, &sub3};
  hipError_t e = hipLaunchCooperativeKernel((void*)mega_kernel, dim3(grid_blocks), dim3(256), args, 0, stream);
  if (e != hipSuccess) fprintf(stderr, "cooperative launch failed: %s (grid %d)\n", hipGetErrorString(e), grid_blocks);
  if (PROBE_PHASE >= 0) {
    int l2 = 0, h2 = 0;
    void* a2[] = {&p, &l2, &h2, &sub3};
    (void)hipLaunchCooperativeKernel((void*)mega_kernel, dim3(grid_blocks), dim3(256), a2, 0, stream);
    int l3 = PROBE_PHASE, h3 = PROBE_PHASE;
    int subp = PROBE_SUB;
    void* a3[] = {&p, &l3, &h3, &subp};
    if (PROBE_PHASE > 0) (void)hipLaunchCooperativeKernel((void*)mega_kernel, dim3(grid_blocks), dim3(256), a3, 0, stream);
  }
#endif
}
```

```cpp
#include <hip/hip_runtime.h>
#include <hip/hip_cooperative_groups.h>
#include <stdint.h>
#include <stdio.h>
namespace cg = cooperative_groups;

typedef unsigned short u16;
typedef __attribute__((ext_vector_type(8))) short bf16x8;
typedef __attribute__((ext_vector_type(4))) short bf16x4;
typedef __attribute__((ext_vector_type(16))) float f32x16;
typedef __attribute__((ext_vector_type(4))) float f32x4;
typedef __attribute__((ext_vector_type(8))) float f32x8;

#ifndef PHASE_MASK
#define PHASE_MASK 0x7ff
#endif
#ifndef REPEAT_MASK
#define REPEAT_MASK 0
#endif
#ifndef DSA_REP_A
#define DSA_REP_A 0
#endif
#ifndef DSA_REP_B
#define DSA_REP_B 0
#endif
#ifndef DSA_REP_C
#define DSA_REP_C 0
#endif
#ifndef PROBE_SUB
#define PROBE_SUB 3
#endif
#ifndef PROBE_PHASE
#define PROBE_PHASE -1
#endif
#ifndef MULTI_LAUNCH
#define MULTI_LAUNCH 0
#endif

static constexpr int T_TOK = 32768;
static constexpr int SEQ = 4096;
static constexpr int DM = 1024;
static constexpr int N_IN0 = 3456;
static constexpr int N_IN1 = 1792;
static constexpr int NPHASE = 11;
static constexpr int SMEM_BYTES = 73728;

struct Params {
  const float* x; const int* pos; const float* norm_mix_g; const float* norm_mlp_g;
  const float* even_w_in; const float* even_w_out; const float* a_q_g; const float* a_k_g;
  const float* b_lb; const float* b_out_g; const float* odd_w_in; const float* odd_w_out;
  const float* c_conv_w; const float* c_conv_b; const float* c_rg_w; const float* c_rg_b;
  const float* c_ig_w; const float* c_ig_b; const float* c_lam; const float* d_q_g; const float* d_k_g;
  const float* d_sinks; const float* mlp_up; const float* mlp_dn;
  float* out; char* ws;
  u16 *wt_in0, *wt_out0, *wt_up0, *wt_dn0, *wt_in1, *wt_out1, *wt_up1, *wt_dn1;
  u16 *abuf, *mixin; float* ss; float2* rope; unsigned* ctr;
  u16 *aq, *kv0, *iq, *ik; float* iw; u16* bq; float* blf; u16 *bi, *bg;
  u16* hid;
  u16* cg; float* cx; u16 *dq, *dkv;
};

__device__ __forceinline__ u16 f2bf(float f) {
  unsigned u = __float_as_uint(f);
  u += 0x7fffu + ((u >> 16) & 1u);
  return (u16)(u >> 16);
}
__device__ __forceinline__ float bf2f(u16 h) { return __uint_as_float(((unsigned)h) << 16); }
__device__ __forceinline__ unsigned pack2(float a, float b) { return (unsigned)f2bf(a) | ((unsigned)f2bf(b) << 16); }
__device__ __forceinline__ float sigmoidf_(float v) { return 1.f / (1.f + __expf(-v)); }
__device__ __forceinline__ float siluf_(float v) { return v * sigmoidf_(v); }
__device__ __forceinline__ float gelu_tanh(float v) {
  float u = 0.7978845608028654f * (v + 0.044715f * v * v * v);
  float th = 1.f - 2.f / (1.f + __expf(2.f * u));
  return 0.5f * v * (1.f + th);
}

__device__ __forceinline__ void store64_bf16(u16* dst, const float* v) {
#pragma unroll
  for (int i = 0; i < 8; ++i) {
    uint4 q;
    q.x = pack2(v[i * 8 + 0], v[i * 8 + 1]); q.y = pack2(v[i * 8 + 2], v[i * 8 + 3]);
    q.z = pack2(v[i * 8 + 4], v[i * 8 + 5]); q.w = pack2(v[i * 8 + 6], v[i * 8 + 7]);
    *(uint4*)(dst + i * 8) = q;
  }
}
__device__ __forceinline__ void store64_f32(float* dst, const float* v) {
#pragma unroll
  for (int i = 0; i < 16; ++i) *(float4*)(dst + i * 4) = make_float4(v[i * 4], v[i * 4 + 1], v[i * 4 + 2], v[i * 4 + 3]);
}
__device__ __forceinline__ void head_norm_rope(float* v, const float* g, const float2* rp, bool donorm, float scale) {
  if (donorm) {
    float ss = 0.f;
#pragma unroll
    for (int d = 0; d < 64; ++d) ss += v[d] * v[d];
    float r = rsqrtf(ss * (1.f / 64.f) + 1e-6f);
#pragma unroll
    for (int c = 0; c < 4; ++c) {
#pragma unroll
      for (int d = c * 16; d < c * 16 + 16; ++d) v[d] = v[d] * r * g[d];
      __builtin_amdgcn_sched_barrier(0);
    }
  }
#pragma unroll
  for (int c = 0; c < 4; ++c) {
#pragma unroll
    for (int d = c * 8; d < c * 8 + 8; ++d) {
      float2 cs = rp[d];
      float x1 = v[d], x2 = v[d + 32];
      v[d] = (x1 * cs.x - x2 * cs.y) * scale;
      v[d + 32] = (x2 * cs.x + x1 * cs.y) * scale;
    }
    __builtin_amdgcn_sched_barrier(0);
  }
}

__device__ __forceinline__ int next_item(unsigned* ctr, int* s_item) {
  __syncthreads();
  if (threadIdx.x == 0) *s_item = (int)atomicAdd(ctr, 1u);
  __syncthreads();
  return *s_item;
}

__device__ void prep_phase(const Params& p, char* smem) {
  const int tid = threadIdx.x;
  float* tile = (float*)smem;
  const int NT = 5920;
  const int NR = T_TOK / 4;
  for (int item = blockIdx.x; item < NT + NR; item += gridDim.x) {
    if (item < NT) {
      const float* src; u16* dst; int K, Nsrc, Ndst, base; int mode = 0;
      if (item < 864) { src = p.even_w_in; dst = p.wt_in0; K = 1024; Nsrc = 3400; Ndst = 3456; base = 0; mode = 1; }
      else if (item < 1120) { src = p.even_w_out; dst = p.wt_out0; K = 1024; Nsrc = 1024; Ndst = 1024; base = 864; }
      else if (item < 2144) { src = p.mlp_up; dst = p.wt_up0; K = 1024; Nsrc = 4096; Ndst = 4096; base = 1120; }
      else if (item < 3168) { src = p.mlp_dn; dst = p.wt_dn0; K = 4096; Nsrc = 1024; Ndst = 1024; base = 2144; }
      else if (item < 3616) { src = p.odd_w_in; dst = p.wt_in1; K = 1024; Nsrc = 1792; Ndst = 1792; base = 3168; }
      else if (item < 3872) { src = p.odd_w_out; dst = p.wt_out1; K = 1024; Nsrc = 1024; Ndst = 1024; base = 3616; }
      else if (item < 4896) { src = p.mlp_up + (size_t)1024 * 4096; dst = p.wt_up1; K = 1024; Nsrc = 4096; Ndst = 4096; base = 3872; }
      else { src = p.mlp_dn + (size_t)1024 * 4096; dst = p.wt_dn1; K = 4096; Nsrc = 1024; Ndst = 1024; base = 4896; }
      int li = item - base;
      int nk = K / 64;
      int n0 = (li / nk) * 64, k0 = (li % nk) * 64;
      __syncthreads();
#pragma unroll 4
      for (int i = 0; i < 16; ++i) {
        int k = i * 4 + (tid >> 6), n = tid & 63;
        int nd = n0 + n;
        int ns = nd;
        if (mode == 1) { ns = (nd < 1352) ? nd : ((nd < 1408) ? -1 : nd - 56); }
        float v = (ns >= 0) ? src[(size_t)(k0 + k) * Nsrc + ns] : 0.f;
        tile[k * 65 + n] = v;
      }
      __syncthreads();
#pragma unroll 4
      for (int i = 0; i < 8; ++i) {
        int n = i * 8 + (tid >> 5), k = (tid & 31) * 2;
        unsigned w = pack2(tile[k * 65 + n], tile[(k + 1) * 65 + n]);
        *(unsigned*)(dst + (size_t)(n0 + n) * K + k0 + k) = w;
      }
    } else {
      int rb = item - NT;
      if (rb == 0 && tid < 32) p.ctr[tid] = 0u;
      int t = rb * 4 + (tid >> 6);
      int lane = tid & 63;
      float ss = 0.f;
#pragma unroll
      for (int i = 0; i < 4; ++i) {
        int col = i * 256 + lane * 4;
        float4 xv = *(const float4*)(p.x + (size_t)t * DM + col);
        float4 gv = *(const float4*)(p.norm_mix_g + col);
        ss += xv.x * xv.x + xv.y * xv.y + xv.z * xv.z + xv.w * xv.w;
        uint2 w; w.x = pack2(xv.x * gv.x, xv.y * gv.y); w.y = pack2(xv.z * gv.z, xv.w * gv.w);
        *(uint2*)(p.abuf + (size_t)t * DM + col) = w;
      }
#pragma unroll
      for (int o = 32; o > 0; o >>= 1) ss += __shfl_xor(ss, o);
      if (lane == 0) {
        p.ss[t] = ss; p.ss[T_TOK + t] = 0.f; p.ss[2 * T_TOK + t] = 0.f; p.ss[3 * T_TOK + t] = 0.f;
      }
      if (lane < 32) {
        float invf = 1.0f / powf(10000.0f, (float)(2 * lane) / 64.0f);
        float ang = (float)p.pos[t] * invf;
        float s, c; sincosf(ang, &s, &c);
        p.rope[(size_t)t * 32 + lane] = make_float2(c, s);
      }
    }
  }
}

enum { EPI_IN0 = 0, EPI_RES = 1, EPI_UP = 2, EPI_IN1 = 3 };

struct GemmArgs {
  const u16* A; const u16* BT; int K; int ntn;
  const float* ssin;
  const float* xold; float* xnew; const float* gnext; float* ssout; u16* anext;
};

__device__ __forceinline__ void epi_rope(const float* rowp, float rstd, const float* g, const float2* rp, float scale, u16* dst) {
  float rn = rstd;
  if (g) {
    float ss = 0.f;
#pragma unroll 8
    for (int d = 0; d < 64; ++d) { float x = rowp[d] * rstd; ss += x * x; }
    rn = rstd * rsqrtf(ss * (1.f / 64.f) + 1e-6f);
  }
#pragma unroll
  for (int c = 0; c < 4; ++c) {
    f32x8 o1, o2;
#pragma unroll
    for (int e = 0; e < 8; ++e) {
      int d = c * 8 + e;
      float x1 = rowp[d] * rn, x2 = rowp[d + 32] * rn;
      if (g) { x1 *= g[d]; x2 *= g[d + 32]; }
      float2 cs = rp[d];
      o1[e] = (x1 * cs.x - x2 * cs.y) * scale;
      o2[e] = (x2 * cs.x + x1 * cs.y) * scale;
    }
    *(uint4*)(dst + c * 8) = make_uint4(pack2(o1[0], o1[1]), pack2(o1[2], o1[3]), pack2(o1[4], o1[5]), pack2(o1[6], o1[7]));
    *(uint4*)(dst + 32 + c * 8) = make_uint4(pack2(o2[0], o2[1]), pack2(o2[2], o2[3]), pack2(o2[4], o2[5]), pack2(o2[6], o2[7]));
    __builtin_amdgcn_sched_barrier(0);
  }
}
enum { F_ID = 0, F_SILU = 1, F_GELU = 2, F_RELU2 = 3 };
template <int F>
__device__ __forceinline__ float epi_fn(float x) {
  if (F == F_SILU) return siluf_(x);
  if (F == F_GELU) return gelu_tanh(x);
  if (F == F_RELU2) { float a = fmaxf(x, 0.f); return a * a; }
  return x;
}
template <int F>
__device__ __forceinline__ void epi_ew_bf16(const float* rowp, float rstd, u16* dst) {
#pragma unroll
  for (int c = 0; c < 4; ++c) {
    float o[16];
#pragma unroll
    for (int e = 0; e < 16; ++e) o[e] = epi_fn<F>(rowp[c * 16 + e] * rstd);
    *(uint4*)(dst + c * 16) = make_uint4(pack2(o[0], o[1]), pack2(o[2], o[3]), pack2(o[4], o[5]), pack2(o[6], o[7]));
    *(uint4*)(dst + c * 16 + 8) = make_uint4(pack2(o[8], o[9]), pack2(o[10], o[11]), pack2(o[12], o[13]), pack2(o[14], o[15]));
    __builtin_amdgcn_sched_barrier(0);
  }
}
__device__ __forceinline__ void epi_ew_f32(const float* rowp, float rstd, float* dst) {
#pragma unroll
  for (int c = 0; c < 4; ++c) {
#pragma unroll
    for (int e = 0; e < 4; ++e) {
      int d = c * 16 + e * 4;
      *(float4*)(dst + d) = make_float4(rowp[d] * rstd, rowp[d + 1] * rstd, rowp[d + 2] * rstd, rowp[d + 3] * rstd);
    }
    __builtin_amdgcn_sched_barrier(0);
  }
}

template <int EPI>
__device__ void gemm_epilogue(const Params& p, const GemmArgs& ga, const float* sC, int m0, int n0) {
  const int tid = threadIdx.x;
  const int r = tid >> 1, seg = tid & 1;
  const int t = m0 + r;
  const int gc = n0 + seg * 64;
  const float* rowp = sC + r * 129 + seg * 64;
  if (EPI == EPI_UP) {
    const int chunk = tid & 15, r16 = tid >> 4;
#pragma unroll
    for (int ps = 0; ps < 8; ++ps) {
      const int row = ps * 16 + r16;
      const int tt = m0 + row;
      const float rs = rsqrtf(ga.ssin[tt] * (1.f / 1024.f) + 1e-6f);
      const float* src = sC + row * 129 + chunk * 8;
      float o[8];
#pragma unroll
      for (int j = 0; j < 8; ++j) { float a = fmaxf(src[j] * rs, 0.f); o[j] = a * a; }
      *(uint4*)(p.hid + (size_t)tt * 4096 + n0 + chunk * 8) = make_uint4(pack2(o[0], o[1]), pack2(o[2], o[3]), pack2(o[4], o[5]), pack2(o[6], o[7]));
    }
    return;
  }
  if (EPI == EPI_RES) {
    const int c4 = tid & 31, r8 = tid >> 5;
    const int col = n0 + c4 * 4;
    float g0 = 0.f, g1 = 0.f, g2 = 0.f, g3 = 0.f;
    if (ga.gnext) { float4 gv = *(const float4*)(ga.gnext + col); g0 = gv.x; g1 = gv.y; g2 = gv.z; g3 = gv.w; }
#pragma unroll 4
    for (int ps = 0; ps < 16; ++ps) {
      const int row = ps * 8 + r8;
      const int tt = m0 + row;
      const float* src = sC + row * 129 + c4 * 4;
      float4 xv = *(const float4*)(ga.xold + (size_t)tt * DM + col);
      float o0 = xv.x + src[0], o1 = xv.y + src[1], o2 = xv.z + src[2], o3 = xv.w + src[3];
      *(float4*)(ga.xnew + (size_t)tt * DM + col) = make_float4(o0, o1, o2, o3);
      if (ga.gnext) {
        float ss = o0 * o0 + o1 * o1 + o2 * o2 + o3 * o3;
        *(uint2*)(ga.anext + (size_t)tt * DM + col) = make_uint2(pack2(o0 * g0, o1 * g1), pack2(o2 * g2, o3 * g3));
        ss += __shfl_xor(ss, 1); ss += __shfl_xor(ss, 2); ss += __shfl_xor(ss, 4); ss += __shfl_xor(ss, 8); ss += __shfl_xor(ss, 16);
        if (c4 == 0) atomicAdd(ga.ssout + tt, ss);
      }
    }
    return;
  }
  if (EPI == EPI_IN0 || EPI == EPI_IN1) {
    int fn = -1, ld = 0, cb = 0; u16* dstb = nullptr; float* dstf = nullptr;
    if (EPI == EPI_IN0) {
      if (n0 == 640) { fn = F_ID; dstb = p.kv0 + 128; ld = 256; cb = 640; }
      else if (n0 >= 1408 && n0 < 1920) { fn = F_SILU; dstb = p.bq; ld = 512; cb = 1408; }
      else if (n0 >= 1920 && n0 < 2432) { fn = 10; dstf = p.blf; ld = 512; cb = 1920; }
      else if (n0 >= 2432 && n0 < 2944) { fn = F_ID; dstb = p.bi; ld = 512; cb = 2432; }
      else if (n0 >= 2944) { fn = F_SILU; dstb = p.bg; ld = 512; cb = 2944; }
    } else {
      if (n0 < 512) { fn = F_GELU; dstb = p.cg; ld = 512; cb = 0; }
      else if (n0 < 1024) { fn = 11; dstf = p.cx; ld = 512; cb = 512; }
      else if (n0 == 1664) { fn = F_ID; dstb = p.dkv + 128; ld = 256; cb = 1664; }
    }
    {
      int rk = 0, rld = 0, rcb = 0; float rscale = 1.f; const float* rg = nullptr; u16* rdst = nullptr;
      if (EPI == EPI_IN0) {
        if (n0 < 512) { rk = 1; rg = p.a_q_g; rscale = 0.125f; rdst = p.aq; rld = 512; rcb = 0; }
        else if (n0 == 512) { rk = 1; rg = p.a_k_g; rdst = p.kv0; rld = 256; rcb = 512; }
        else if (n0 >= 768 && n0 < 1280) { rk = 1; rdst = p.iq; rld = 512; rcb = 768; }
      } else {
        if (n0 >= 1024 && n0 < 1536) { rk = 1; rg = p.d_q_g; rscale = 0.125f; rdst = p.dq; rld = 512; rcb = 1024; }
        else if (n0 == 1536) { rk = 1; rg = p.d_k_g; rdst = p.dkv; rld = 256; rcb = 1536; }
      }
      if (rk) {
        const int c = tid & 15, r16 = tid >> 4;
        const int hh = c >> 3, cc = c & 7;
        const float sgn = (cc < 4) ? -1.f : 1.f;
        const int dd0 = (cc & 3) * 8;
#pragma unroll 2
        for (int ps = 0; ps < 8; ++ps) {
          const int row = ps * 16 + r16;
          const int tt = m0 + row;
          const float rs = rsqrtf(ga.ssin[tt] * (1.f / 1024.f) + 1e-6f);
          const float* sm = sC + row * 129 + hh * 64 + cc * 8;
          const float* sp = sC + row * 129 + hh * 64 + (cc ^ 4) * 8;
          f32x8 mine, part;
          float ssq = 0.f;
#pragma unroll
          for (int j = 0; j < 8; ++j) { mine[j] = sm[j] * rs; part[j] = sp[j] * rs; ssq += mine[j] * mine[j]; }
          if (rg) {
            ssq += __shfl_xor(ssq, 1); ssq += __shfl_xor(ssq, 2); ssq += __shfl_xor(ssq, 4);
            const float rn = rsqrtf(ssq * (1.f / 64.f) + 1e-6f);
#pragma unroll
            for (int j = 0; j < 8; ++j) { mine[j] *= rn * rg[cc * 8 + j]; part[j] *= rn * rg[(cc ^ 4) * 8 + j]; }
          }
          const float2* rp2 = p.rope + (size_t)tt * 32 + dd0;
          f32x8 o;
#pragma unroll
          for (int j = 0; j < 8; ++j) {
            float2 cs = rp2[j];
            o[j] = (mine[j] * cs.x + sgn * part[j] * cs.y) * rscale;
          }
          *(uint4*)(rdst + (size_t)tt * rld + (n0 - rcb) + c * 8) = make_uint4(pack2(o[0], o[1]), pack2(o[2], o[3]), pack2(o[4], o[5]), pack2(o[6], o[7]));
        }
        return;
      }
    }
    if (fn >= 0 && fn < 10) {
      const int chunk = tid & 15, r16 = tid >> 4;
#pragma unroll 2
      for (int ps = 0; ps < 8; ++ps) {
        const int row = ps * 16 + r16;
        const int tt = m0 + row;
        const float rs = rsqrtf(ga.ssin[tt] * (1.f / 1024.f) + 1e-6f);
        const float* src = sC + row * 129 + chunk * 8;
        float o[8];
#pragma unroll
        for (int j = 0; j < 8; ++j) {
          float x = src[j] * rs;
          o[j] = (fn == F_SILU) ? siluf_(x) : ((fn == F_GELU) ? gelu_tanh(x) : x);
        }
        *(uint4*)(dstb + (size_t)tt * ld + (n0 - cb) + chunk * 8) = make_uint4(pack2(o[0], o[1]), pack2(o[2], o[3]), pack2(o[4], o[5]), pack2(o[6], o[7]));
      }
      return;
    }
    if (fn >= 10) {
      const int c4 = tid & 31, r8 = tid >> 5;
      const int cc = (n0 - cb) + c4 * 4;
      float lb0 = 0.f, lb1 = 0.f, lb2 = 0.f, lb3 = 0.f;
      if (fn == 10) {
        lb0 = sigmoidf_(p.b_lb[cc] - p.b_lb[512 + cc]); lb1 = sigmoidf_(p.b_lb[cc + 1] - p.b_lb[512 + cc + 1]);
        lb2 = sigmoidf_(p.b_lb[cc + 2] - p.b_lb[512 + cc + 2]); lb3 = sigmoidf_(p.b_lb[cc + 3] - p.b_lb[512 + cc + 3]);
      }
#pragma unroll 2
      for (int ps = 0; ps < 16; ++ps) {
        const int row = ps * 8 + r8;
        const int tt = m0 + row;
        const float rs = rsqrtf(ga.ssin[tt] * (1.f / 1024.f) + 1e-6f);
        const float* src = sC + row * 129 + c4 * 4;
        float o0 = src[0] * rs, o1 = src[1] * rs, o2 = src[2] * rs, o3 = src[3] * rs;
        if (fn == 10) {
          o0 = __logf(lb0 + (1.f - lb0) * sigmoidf_(o0)); o1 = __logf(lb1 + (1.f - lb1) * sigmoidf_(o1));
          o2 = __logf(lb2 + (1.f - lb2) * sigmoidf_(o2)); o3 = __logf(lb3 + (1.f - lb3) * sigmoidf_(o3));
        }
        *(float4*)(dstf + (size_t)tt * ld + cc) = make_float4(o0, o1, o2, o3);
      }
      return;
    }
  }
  const float rstd = rsqrtf(ga.ssin[t] * (1.f / 1024.f) + 1e-6f);

  const float2* rp = p.rope + (size_t)t * 32;
  if (EPI == EPI_IN0) {
    if (gc >= 1280 && gc < 1344) epi_rope(rowp, rstd, nullptr, rp, 1.f, p.ik + (size_t)t * 64);
    else if (gc >= 1344 && gc < 1408) {
      *(float4*)(p.iw + (size_t)t * 8) = make_float4(rowp[0] * rstd, rowp[1] * rstd, rowp[2] * rstd, rowp[3] * rstd);
      *(float4*)(p.iw + (size_t)t * 8 + 4) = make_float4(rowp[4] * rstd, rowp[5] * rstd, rowp[6] * rstd, rowp[7] * rstd);
    }
  }
}

#define G_LOAD(P, kt_) { \
  P##a0 = *(const uint4*)(Ag + (size_t)(0) * K + (kt_) * 64);  P##a1 = *(const uint4*)(Ag + (size_t)(32) * K + (kt_) * 64); \
  P##a2 = *(const uint4*)(Ag + (size_t)(64) * K + (kt_) * 64); P##a3 = *(const uint4*)(Ag + (size_t)(96) * K + (kt_) * 64); \
  P##b0 = *(const uint4*)(Bg + (size_t)(0) * K + (kt_) * 64);  P##b1 = *(const uint4*)(Bg + (size_t)(32) * K + (kt_) * 64); \
  P##b2 = *(const uint4*)(Bg + (size_t)(64) * K + (kt_) * 64); P##b3 = *(const uint4*)(Bg + (size_t)(96) * K + (kt_) * 64); }
#define S_STORE(P, buf_) { \
  *(uint4*)(sAw + (buf_) * 128 * 72 + 0 * 72) = P##a0;  *(uint4*)(sAw + (buf_) * 128 * 72 + 32 * 72) = P##a1; \
  *(uint4*)(sAw + (buf_) * 128 * 72 + 64 * 72) = P##a2; *(uint4*)(sAw + (buf_) * 128 * 72 + 96 * 72) = P##a3; \
  *(uint4*)(sBw + (buf_) * 128 * 72 + 0 * 72) = P##b0;  *(uint4*)(sBw + (buf_) * 128 * 72 + 32 * 72) = P##b1; \
  *(uint4*)(sBw + (buf_) * 128 * 72 + 64 * 72) = P##b2; *(uint4*)(sBw + (buf_) * 128 * 72 + 96 * 72) = P##b3; }
__device__ __forceinline__ void mma_tile(f32x16& acc00, f32x16& acc01, f32x16& acc10, f32x16& acc11, const u16* sA, const u16* sB, int buf, int wm, int wn, int lr, int lh) {
  const u16* a_base = sA + buf * 128 * 72 + (wm * 64 + lr) * 72 + lh * 8;
  const u16* b_base = sB + buf * 128 * 72 + (wn * 64 + lr) * 72 + lh * 8;
#pragma unroll
  for (int ks = 0; ks < 4; ++ks) {
    bf16x8 a0 = *(const bf16x8*)(a_base + ks * 16);
    bf16x8 a1 = *(const bf16x8*)(a_base + 32 * 72 + ks * 16);
    bf16x8 b0 = *(const bf16x8*)(b_base + ks * 16);
    bf16x8 b1 = *(const bf16x8*)(b_base + 32 * 72 + ks * 16);
    acc00 = __builtin_amdgcn_mfma_f32_32x32x16_bf16(a0, b0, acc00, 0, 0, 0);
    acc01 = __builtin_amdgcn_mfma_f32_32x32x16_bf16(a0, b1, acc01, 0, 0, 0);
    acc10 = __builtin_amdgcn_mfma_f32_32x32x16_bf16(a1, b0, acc10, 0, 0, 0);
    acc11 = __builtin_amdgcn_mfma_f32_32x32x16_bf16(a1, b1, acc11, 0, 0, 0);
  }
}

template <int EPI>
__device__ void gemm_phase(const Params& p, const GemmArgs& ga, char* smem) {
  const int tid = threadIdx.x, lane = tid & 63, wave = __builtin_amdgcn_readfirstlane(tid >> 6);
  const int wm = wave >> 1, wn = wave & 1;
  const int lr = lane & 31, lh = lane >> 5;
  const int K = ga.K;
  const int nk = K / 64;
  u16* sA = (u16*)smem;
  u16* sB = (u16*)(smem + 2 * 128 * 72 * 2);
  float* sC = (float*)smem;
  const int xcd = blockIdx.x & 7, slot = blockIdx.x >> 3, nslot = gridDim.x >> 3;
  const int nlocal = 32 * ga.ntn;
  for (int lt = slot; lt < nlocal; lt += nslot) {
    const int pp = lt & 7, rest = lt >> 3;
    const int tn = rest % ga.ntn, pg = rest / ga.ntn;
    const int tm = (pg * 8 + pp) * 8 + xcd;
    const int m0 = tm * 128, n0 = tn * 128;
    const u16* Ap = ga.A + (size_t)m0 * K;
    const u16* Bp = ga.BT + (size_t)n0 * K;
    f32x16 acc00, acc01, acc10, acc11;
#pragma unroll
    for (int e = 0; e < 16; ++e) { acc00[e] = 0.f; acc01[e] = 0.f; acc10[e] = 0.f; acc11[e] = 0.f; }
    const int srow = tid >> 3, scol = (tid & 7) * 8;
    const u16* Ag = Ap + (size_t)srow * K + scol;
    const u16* Bg = Bp + (size_t)srow * K + scol;
    u16* sAw = sA + srow * 72 + scol;
    u16* sBw = sB + srow * 72 + scol;
    uint4 p0a0, p0a1, p0a2, p0a3, p0b0, p0b1, p0b2, p0b3, p1a0, p1a1, p1a2, p1a3, p1b0, p1b1, p1b2, p1b3;
    G_LOAD(p0, 0)
    G_LOAD(p1, 1)
    S_STORE(p0, 0)
    __syncthreads();
    for (int kt = 0; kt < nk; kt += 2) {
      if (kt + 2 < nk) G_LOAD(p0, kt + 2)
      __builtin_amdgcn_sched_barrier(0);
      mma_tile(acc00, acc01, acc10, acc11, sA, sB, 0, wm, wn, lr, lh);
      S_STORE(p1, 1)
      __syncthreads();
      if (kt + 3 < nk) G_LOAD(p1, kt + 3)
      __builtin_amdgcn_sched_barrier(0);
      mma_tile(acc00, acc01, acc10, acc11, sA, sB, 1, wm, wn, lr, lh);
      if (kt + 2 < nk) S_STORE(p0, 0)
      __syncthreads();
    }
    {
      float* cb = sC + (wm * 64 + 4 * lh) * 129 + wn * 64 + lr;
#pragma unroll
      for (int e = 0; e < 16; ++e) {
        cb[((e & 3) + 8 * (e >> 2)) * 129] = acc00[e];
        cb[((e & 3) + 8 * (e >> 2)) * 129 + 32] = acc01[e];
        cb[(32 + (e & 3) + 8 * (e >> 2)) * 129] = acc10[e];
        cb[(32 + (e & 3) + 8 * (e >> 2)) * 129 + 32] = acc11[e];
      }
    }
    __syncthreads();
    gemm_epilogue<EPI>(p, ga, sC, m0, n0);
    __syncthreads();
  }
}

__device__ void attend_wave(const u16* Qb, const u16* KV, size_t tokbase, int tq, const u16* sel, int first_key, int nsel,
                            const float* sinks, float* sP, u16* outp) {
  const int lane = threadIdx.x & 63;
  const int n = lane & 15, G = lane >> 4;
  bf16x8 bq[4];
#pragma unroll
  for (int ks = 0; ks < 4; ++ks) {
    int kdim = ks * 32 + 8 * G;
    int kg = kdim >> 6, d0 = kdim & 63;
    bf16x8 z = {0, 0, 0, 0, 0, 0, 0, 0};
    if (n < 8 && (n >> 2) == kg) z = *(const bf16x8*)(Qb + (tokbase + tq) * 512 + n * 64 + d0);
    bq[ks] = z;
  }
  const int ntile = (nsel + 15) >> 4;
  bf16x8 ka0, ka1, ka2, ka3, kb0, kb1, kb2, kb3, kc0, kc1, kc2, kc3, kd0, kd1, kd2, kd3;
  float mx = -INFINITY;
#define QK_GATHER(A0, A1, A2, A3, ti_) { int slot = (ti_) * 16 + n; slot = slot < nsel ? slot : nsel - 1; \
    int idx = (int)sel[slot]; const u16* kr = KV + (tokbase + idx) * 256 + 8 * G; \
    A0 = *(const bf16x8*)(kr); A1 = *(const bf16x8*)(kr + 32); A2 = *(const bf16x8*)(kr + 64); A3 = *(const bf16x8*)(kr + 96); }
#define QK_USE(A0, A1, A2, A3, ti_) { f32x4 c = {0.f, 0.f, 0.f, 0.f}; \
    c = __builtin_amdgcn_mfma_f32_16x16x32_bf16(A0, bq[0], c, 0, 0, 0); \
    c = __builtin_amdgcn_mfma_f32_16x16x32_bf16(A1, bq[1], c, 0, 0, 0); \
    c = __builtin_amdgcn_mfma_f32_16x16x32_bf16(A2, bq[2], c, 0, 0, 0); \
    c = __builtin_amdgcn_mfma_f32_16x16x32_bf16(A3, bq[3], c, 0, 0, 0); \
    mx = fmaxf(mx, fmaxf(fmaxf(c[0], c[1]), fmaxf(c[2], c[3]))); \
    if (n < 8) { float* dp = sP + ((ti_) * 16 + 4 * G) * 8 + n; dp[0] = c[0]; dp[8] = c[1]; dp[16] = c[2]; dp[24] = c[3]; } }
  QK_GATHER(ka0, ka1, ka2, ka3, 0)
  QK_GATHER(kb0, kb1, kb2, kb3, 1)
  QK_GATHER(kc0, kc1, kc2, kc3, 2)
  QK_GATHER(kd0, kd1, kd2, kd3, 3)
  for (int ti0 = 0; ti0 < ntile; ti0 += 4) {
    bf16x8 ca0 = ka0, ca1 = ka1, ca2 = ka2, ca3 = ka3, cb0 = kb0, cb1 = kb1, cb2 = kb2, cb3 = kb3;
    bf16x8 cc0 = kc0, cc1 = kc1, cc2 = kc2, cc3 = kc3, cd0 = kd0, cd1 = kd1, cd2 = kd2, cd3 = kd3;
    if (ti0 + 4 < ntile) {
      QK_GATHER(ka0, ka1, ka2, ka3, ti0 + 4)
      QK_GATHER(kb0, kb1, kb2, kb3, ti0 + 5)
      QK_GATHER(kc0, kc1, kc2, kc3, ti0 + 6)
      QK_GATHER(kd0, kd1, kd2, kd3, ti0 + 7)
    }
    QK_USE(ca0, ca1, ca2, ca3, ti0)
    if (ti0 + 1 < ntile) QK_USE(cb0, cb1, cb2, cb3, ti0 + 1)
    if (ti0 + 2 < ntile) QK_USE(cc0, cc1, cc2, cc3, ti0 + 2)
    if (ti0 + 3 < ntile) QK_USE(cd0, cd1, cd2, cd3, ti0 + 3)
  }
#undef QK_GATHER
#undef QK_USE
  __builtin_amdgcn_wave_barrier();
  const int hh = lane & 7, sg = lane >> 3;
  mx = fmaxf(mx, __shfl_xor(mx, 16));
  mx = fmaxf(mx, __shfl_xor(mx, 32));
  float m = __shfl(mx, hh);
  float sk = 0.f;
  if (sinks) { sk = sinks[hh]; m = fmaxf(m, sk); }
  float sum = 0.f;
  for (int sl_ = sg; sl_ < nsel; sl_ += 8) {
    float e = __expf(sP[sl_ * 8 + hh] - m);
    sP[sl_ * 8 + hh] = e; sum += e;
  }
  sum += __shfl_xor(sum, 8);
  sum += __shfl_xor(sum, 16);
  sum += __shfl_xor(sum, 32);
  if (sinks) sum += __expf(sk - m);
  const float inv = 1.f / sum;
  __builtin_amdgcn_wave_barrier();
  const int kq = lane >> 4, c = lane & 15;
  const int g = c >> 3;
  f32x8 o0 = {0.f, 0.f, 0.f, 0.f, 0.f, 0.f, 0.f, 0.f}, o1 = o0, o2 = o0, o3 = o0;
  const u16* vbase = KV + tokbase * 256 + 128 + 8 * c;
  const int ngrp = (nsel + 3) >> 2;
  uint4 vq0, vq1, vq2, vq3, vq4, vq5, vq6, vq7;
#define PV_GATHER(V, it_) { int s_ = (it_) * 4 + kq; s_ = s_ < nsel ? s_ : nsel - 1; \
    int idx = (int)sel[s_]; V = *(const uint4*)(vbase + (size_t)idx * 256); }
#define PV_USE(V, it_) { int s_ = (it_) * 4 + kq; bool valid = s_ < nsel; int sc_ = valid ? s_ : nsel - 1; \
    float4 pp = *(const float4*)(sP + sc_ * 8 + 4 * g); if (!valid) pp = make_float4(0.f, 0.f, 0.f, 0.f); \
    f32x8 ve; \
    ve[0] = __uint_as_float(V.x << 16); ve[1] = __uint_as_float(V.x & 0xffff0000u); \
    ve[2] = __uint_as_float(V.y << 16); ve[3] = __uint_as_float(V.y & 0xffff0000u); \
    ve[4] = __uint_as_float(V.z << 16); ve[5] = __uint_as_float(V.z & 0xffff0000u); \
    ve[6] = __uint_as_float(V.w << 16); ve[7] = __uint_as_float(V.w & 0xffff0000u); \
    o0 += pp.x * ve; o1 += pp.y * ve; o2 += pp.z * ve; o3 += pp.w * ve; }
  PV_GATHER(vq0, 0) PV_GATHER(vq1, 1) PV_GATHER(vq2, 2) PV_GATHER(vq3, 3)
  PV_GATHER(vq4, 4) PV_GATHER(vq5, 5) PV_GATHER(vq6, 6) PV_GATHER(vq7, 7)
  for (int it0 = 0; it0 < ngrp; it0 += 8) {
    uint4 c0 = vq0, c1 = vq1, c2 = vq2, c3 = vq3, c4 = vq4, c5 = vq5, c6 = vq6, c7 = vq7;
    if (it0 + 8 < ngrp) {
      PV_GATHER(vq0, it0 + 8) PV_GATHER(vq1, it0 + 9) PV_GATHER(vq2, it0 + 10) PV_GATHER(vq3, it0 + 11)
      PV_GATHER(vq4, it0 + 12) PV_GATHER(vq5, it0 + 13) PV_GATHER(vq6, it0 + 14) PV_GATHER(vq7, it0 + 15)
    }
    PV_USE(c0, it0) PV_USE(c1, it0 + 1) PV_USE(c2, it0 + 2) PV_USE(c3, it0 + 3)
    PV_USE(c4, it0 + 4) PV_USE(c5, it0 + 5) PV_USE(c6, it0 + 6) PV_USE(c7, it0 + 7)
  }
#undef PV_GATHER
#undef PV_USE
#pragma unroll
  for (int e = 0; e < 8; ++e) {
    float v;
    v = o0[e]; v += __shfl_xor(v, 16); v += __shfl_xor(v, 32); o0[e] = v;
    v = o1[e]; v += __shfl_xor(v, 16); v += __shfl_xor(v, 32); o1[e] = v;
    v = o2[e]; v += __shfl_xor(v, 16); v += __shfl_xor(v, 32); o2[e] = v;
    v = o3[e]; v += __shfl_xor(v, 16); v += __shfl_xor(v, 32); o3[e] = v;
  }
  float iv = __shfl(inv, 4 * g + kq);
  f32x8 r8 = o0;
  r8 = (kq == 1) ? o1 : r8;
  r8 = (kq == 2) ? o2 : r8;
  r8 = (kq == 3) ? o3 : r8;
  r8 *= iv;
  *(uint4*)(outp + (4 * g + kq) * 64 + ((8 * c) & 63)) = make_uint4(pack2(r8[0], r8[1]), pack2(r8[2], r8[3]), pack2(r8[4], r8[5]), pack2(r8[6], r8[7]));
}

__device__ __noinline__ void dsa_select_unused(int); __device__ __forceinline__ void dsa_select(const u16* sc, unsigned* hs, u16* sl, int n, int target, int lane) {
  const int niter = (n + 63) >> 6;
  unsigned prefix = 0u;
  int need = target;
  for (int pass = 0; pass < 2; ++pass) {
    hs[lane] = 0u; hs[lane + 64] = 0u; hs[lane + 128] = 0u; hs[lane + 192] = 0u;
    asm volatile("s_waitcnt lgkmcnt(0)" ::: "memory");
#pragma unroll 2
    for (int i = 0; i < niter; ++i) {
      int key = i * 64 + lane;
      unsigned v = sc[key];
      bool act = (key < n) && (pass == 0 || (v >> 8) == prefix);
      unsigned bin = pass == 0 ? (v >> 8) : (v & 255u);
      if (act) atomicAdd(&hs[bin], 1u);
    }
    asm volatile("s_waitcnt lgkmcnt(0)" ::: "memory");
    uint4 cv = *(const uint4*)(hs + 4 * lane);
    int c0 = cv.x, c1 = cv.y, c2 = cv.z, c3 = cv.w;
    int sl4 = c0 + c1 + c2 + c3;
    int incl = sl4;
#pragma unroll
    for (int o = 1; o < 64; o <<= 1) {
      int tv = __shfl_down(incl, o);
      if (lane + o < 64) incl += tv;
    }
    int excl = incl - sl4;
    bool mine = (excl < need) && (need <= incl);
    int bsel = 0, above = excl;
    if (mine) {
      if (above + c3 >= need) bsel = 3;
      else { above += c3; if (above + c2 >= need) bsel = 2; else { above += c2; if (above + c1 >= need) bsel = 1; else { above += c1; bsel = 0; } } }
    }
    unsigned long long bm = __ballot(mine);
    int src = __ffsll((long long)bm) - 1;
    int binfull = __shfl(4 * lane + bsel, src);
    int abovefull = __shfl(above, src);
    prefix = (pass == 0) ? (unsigned)binfull : ((prefix << 8) | (unsigned)binfull);
    need -= abovefull;
    asm volatile("s_waitcnt lgkmcnt(0)" ::: "memory");
  }
  const unsigned Tthr = prefix;
  const int cgt = target - need;
  int posg = 0, post = 0;
  const unsigned long long lt = (1ull << lane) - 1ull;
#pragma unroll 4
  for (int i = 0; i < niter; ++i) {
    int key = i * 64 + lane;
    unsigned v = sc[key];
    bool inr = key < n;
    bool isg = inr && (v > Tthr);
    bool ist = inr && (v == Tthr);
    unsigned long long bg = __ballot(isg), bt = __ballot(ist);
    int rg = posg + __popcll(bg & lt);
    int rt = post + __popcll(bt & lt);
    if (isg) sl[rg] = (u16)key;
    if (ist && rt < need) sl[cgt + rt] = (u16)key;
    posg += __popcll(bg); post += __popcll(bt);
  }
}

__device__ void dsa_item(const Params& p, int b, int q0, char* smem, int sub) {
  u16* score16 = (u16*)smem;
  unsigned* hist = (unsigned*)(smem + 65536);
  u16* selL = (u16*)(smem + 65536 + 4096);
  const int tid = threadIdx.x, lane = tid & 63, wave = __builtin_amdgcn_readfirstlane(tid >> 6);
  const int lr = lane & 31, lh = lane >> 5;
  const size_t tokbase = (size_t)b * SEQ;
  const int nkeys = q0 + 8;
  const int ntile = (nkeys + 31) >> 5;
  if (!(sub & 4)) {
    const int m = lr;
    const int i_ = m >> 3, gg = (m >> 2) & 1, j_ = m & 3;
    const int qq = 2 * gg + (i_ >> 1), hh = (i_ & 1) * 4 + j_;
    const u16* ap0 = p.iq + (tokbase + q0 + qq) * 512 + hh * 64 + lh * 8;
    const u16* ap1 = ap0 + 4 * 512;
    bf16x8 a00 = *(const bf16x8*)(ap0), a01 = *(const bf16x8*)(ap0 + 16), a02 = *(const bf16x8*)(ap0 + 32), a03 = *(const bf16x8*)(ap0 + 48);
    bf16x8 a10 = *(const bf16x8*)(ap1), a11 = *(const bf16x8*)(ap1 + 16), a12 = *(const bf16x8*)(ap1 + 32), a13 = *(const bf16x8*)(ap1 + 48);
    f32x16 w0, w1;
#pragma unroll
    for (int r = 0; r < 16; ++r) {
      w0[r] = p.iw[(tokbase + q0 + 2 * lh + (r >> 3)) * 8 + (r & 7)];
      w1[r] = p.iw[(tokbase + q0 + 4 + 2 * lh + (r >> 3)) * 8 + (r & 7)];
    }
    const u16* ikb = p.ik + tokbase * 64 + lr * 64 + lh * 8;
    bf16x8 n0, n1, n2, n3;
    if (wave < ntile) {
      const u16* bp = ikb + (size_t)wave * 32 * 64;
      n0 = *(const bf16x8*)(bp); n1 = *(const bf16x8*)(bp + 16); n2 = *(const bf16x8*)(bp + 32); n3 = *(const bf16x8*)(bp + 48);
    }
    for (int kt = wave; kt < ntile; kt += 4) {
      int key = kt * 32 + lr;
      bf16x8 b0 = n0, b1 = n1, b2 = n2, b3 = n3;
      if (kt + 4 < ntile) {
        const u16* bp = ikb + (size_t)(kt + 4) * 32 * 64;
        n0 = *(const bf16x8*)(bp); n1 = *(const bf16x8*)(bp + 16); n2 = *(const bf16x8*)(bp + 32); n3 = *(const bf16x8*)(bp + 48);
      }
      f32x16 c0, c1;
#pragma unroll
      for (int e = 0; e < 16; ++e) { c0[e] = 0.f; c1[e] = 0.f; }
      c0 = __builtin_amdgcn_mfma_f32_32x32x16_bf16(a00, b0, c0, 0, 0, 0);
      c1 = __builtin_amdgcn_mfma_f32_32x32x16_bf16(a10, b0, c1, 0, 0, 0);
      c0 = __builtin_amdgcn_mfma_f32_32x32x16_bf16(a01, b1, c0, 0, 0, 0);
      c1 = __builtin_amdgcn_mfma_f32_32x32x16_bf16(a11, b1, c1, 0, 0, 0);
      c0 = __builtin_amdgcn_mfma_f32_32x32x16_bf16(a02, b2, c0, 0, 0, 0);
      c1 = __builtin_amdgcn_mfma_f32_32x32x16_bf16(a12, b2, c1, 0, 0, 0);
      c0 = __builtin_amdgcn_mfma_f32_32x32x16_bf16(a03, b3, c0, 0, 0, 0);
      c1 = __builtin_amdgcn_mfma_f32_32x32x16_bf16(a13, b3, c1, 0, 0, 0);
      float s0 = 0.f, s1 = 0.f, s2 = 0.f, s3 = 0.f;
#pragma unroll
      for (int r = 0; r < 8; ++r) {
        s0 += fmaxf(c0[r], 0.f) * w0[r]; s1 += fmaxf(c0[8 + r], 0.f) * w0[8 + r];
        s2 += fmaxf(c1[r], 0.f) * w1[r]; s3 += fmaxf(c1[8 + r], 0.f) * w1[8 + r];
      }
      f32x4 sv = {s0, s1, s2, s3};
#pragma unroll
      for (int k = 0; k < 4; ++k) {
        float sf = sv[k] + 0.f;
        unsigned u = __float_as_uint(sf);
        unsigned ua = u & 0x7fffffffu;
        int mag = (int)(ua >> 13) - ((127 - 20) << 10);
        mag = mag < 0 ? 0 : (mag > 0x7fff ? 0x7fff : mag);
        unsigned k16 = (u & 0x80000000u) ? (unsigned)(0x7fff - mag) : (0x8000u | (unsigned)mag);
        k16 = k16 < 1u ? 1u : k16;
        int ql = (k >> 1) * 4 + 2 * lh + (k & 1);
        unsigned v16 = (key > q0 + ql) ? 0u : k16;
        score16[ql * 4096 + key] = (u16)v16;
      }
    }
  }
  __syncthreads();
#pragma unroll 1
  for (int rep = 0; rep < 2; ++rep) {
    const int ql = wave + 4 * rep;
    const int q = q0 + ql;
    const int n = q + 1;
    const int target = n < 256 ? n : 256;
    if (!(sub & 4)) dsa_select(score16 + ql * 4096, hist + wave * 256, selL + ql * 256, n, target, lane);
  }
  __syncthreads();
#pragma unroll 1
  for (int rep = 0; rep < 2; ++rep) {
    const int ql = wave + 4 * rep;
    const int q = q0 + ql;
    const int n = q + 1;
    const int target = n < 256 ? n : 256;
    if (!(sub & 8))
      attend_wave(p.aq, p.kv0, tokbase, q, selL + ql * 256, 0, target, nullptr, (float*)(score16 + wave * 4096), p.mixin + (tokbase + q) * 1024);
  }
}

__device__ void hgrn_item(const Params& p, int b, int h, char* smem) {
  u16* sQ = (u16*)smem;
  u16* sK = (u16*)(smem + 17408);
  u16* sKT = (u16*)(smem + 34816);
  u16* sVT = (u16*)(smem + 34816 + 18432);
  float* sDecay = (float*)(smem + 71680);
  float* sTot = (float*)(smem + 71680 + 512);
  float* sO = (float*)smem;
  const int tid = threadIdx.x, lane = tid & 63, wave = __builtin_amdgcn_readfirstlane(tid >> 6);
  const int lr = lane & 31, lh = lane >> 5;
  const size_t tokbase = (size_t)b * SEQ;
  f32x16 S[4];
#pragma unroll
  for (int i = 0; i < 4; ++i)
#pragma unroll
    for (int e = 0; e < 16; ++e) S[i][e] = 0.f;
  for (int c = 0; c < 64; ++c) {
    const int t0 = c * 64;
    __syncthreads();
    uint4 gv0, gv1, gv2, gv3;
    {
      const size_t tok0 = tokbase + t0;
      float* sLF = (float*)smem;
      u16* sQst = sKT;
      float4 l0, l1, l2, l3, l4, l5, l6, l7;
      {
        const int c4 = tid & 31, r0 = tid >> 5;
        const float* lp = p.blf + (tok0 + r0) * 512 + h * 128 + c4 * 4;
        l0 = *(const float4*)(lp); l1 = *(const float4*)(lp + 8 * 512); l2 = *(const float4*)(lp + 16 * 512);
        l3 = *(const float4*)(lp + 24 * 512); l4 = *(const float4*)(lp + 32 * 512); l5 = *(const float4*)(lp + 40 * 512);
        l6 = *(const float4*)(lp + 48 * 512); l7 = *(const float4*)(lp + 56 * 512);
      }
      uint4 q0, q1, q2, q3;
      {
        const int c8 = tid & 15, r0 = tid >> 4;
        const u16* qp = p.bq + (tok0 + r0) * 512 + h * 128 + c8 * 8;
        q0 = *(const uint4*)(qp); q1 = *(const uint4*)(qp + 16 * 512); q2 = *(const uint4*)(qp + 32 * 512); q3 = *(const uint4*)(qp + 48 * 512);
      }
      const int tt = tid >> 2, v0 = (tid & 3) * 32;
      const u16* vp = p.bi + (tok0 + tt) * 512 + h * 128 + v0;
      uint4 w0 = *(const uint4*)(vp), w1 = *(const uint4*)(vp + 8), w2 = *(const uint4*)(vp + 16), w3 = *(const uint4*)(vp + 24);
      const u16* gp = p.bg + (tok0 + tt) * 512 + h * 128 + v0;
      gv0 = *(const uint4*)(gp); gv1 = *(const uint4*)(gp + 8); gv2 = *(const uint4*)(gp + 16); gv3 = *(const uint4*)(gp + 24);
      {
        const int c4 = tid & 31, r0 = tid >> 5;
        float* sp = sLF + r0 * 128 + c4 * 4;
        *(float4*)(sp) = l0; *(float4*)(sp + 8 * 128) = l1; *(float4*)(sp + 16 * 128) = l2; *(float4*)(sp + 24 * 128) = l3;
        *(float4*)(sp + 32 * 128) = l4; *(float4*)(sp + 40 * 128) = l5; *(float4*)(sp + 48 * 128) = l6; *(float4*)(sp + 56 * 128) = l7;
        const int c8 = tid & 15, r1 = tid >> 4;
        u16* qs = sQst + r1 * 128 + c8 * 8;
        *(uint4*)(qs) = q0; *(uint4*)(qs + 16 * 128) = q1; *(uint4*)(qs + 32 * 128) = q2; *(uint4*)(qs + 48 * 128) = q3;
      }
      {
        u16* vt = sVT + v0 * 72 + tt;
#define VT_PUT(W, e_) { vt[(2 * (e_)) * 72] = (u16)((W) & 0xffffu); vt[(2 * (e_) + 1) * 72] = (u16)((W) >> 16); }
        VT_PUT(w0.x, 0) VT_PUT(w0.y, 1) VT_PUT(w0.z, 2) VT_PUT(w0.w, 3)
        VT_PUT(w1.x, 4) VT_PUT(w1.y, 5) VT_PUT(w1.z, 6) VT_PUT(w1.w, 7)
        VT_PUT(w2.x, 8) VT_PUT(w2.y, 9) VT_PUT(w2.z, 10) VT_PUT(w2.w, 11)
        VT_PUT(w3.x, 12) VT_PUT(w3.y, 13) VT_PUT(w3.z, 14) VT_PUT(w3.w, 15)
#undef VT_PUT
      }
      __syncthreads();
      const int d = tid & 127, half = tid >> 7;
      float lfr[32];
      unsigned short qr[32];
      float tot = 0.f;
#pragma unroll
      for (int i = 0; i < 32; ++i) {
        lfr[i] = sLF[(half * 32 + i) * 128 + d];
        qr[i] = sQst[(half * 32 + i) * 128 + d];
        tot += lfr[i];
      }
      sTot[half * 128 + d] = tot;
      __syncthreads();
      float t0v = sTot[d], t1v = sTot[128 + d];
      float blast = t0v + t1v;
      float run = half ? t0v : 0.f;
      if (half == 0) sDecay[d] = __expf(blast);
      u16* sQw = sQ + (half * 32) * 136 + d;
      u16* sKw = sK + (half * 32) * 136 + d;
      u16* sKTw = sKT + d * 72 + half * 32;
#pragma unroll
      for (int i = 0; i < 32; ++i) {
        float qvi = bf2f(qr[i]);
        float lfi = lfr[i];
        run += lfi;
        float bc = fmaxf(run, -80.f);
        float e = __expf(bc);
        float kf = 1.f - __expf(lfi);
        float qt = qvi * e;
        float kt = kf * __expf(-bc);
        sQw[i * 136] = f2bf(qt);
        u16 kb = f2bf(kt);
        sKw[i * 136] = kb;
        sKTw[i] = kb;
      }
    }
    __syncthreads();
    __builtin_amdgcn_sched_barrier(0);
    f32x16 X00, X01, X11;
#pragma unroll
    for (int e = 0; e < 16; ++e) { X00[e] = 0.f; X01[e] = 0.f; X11[e] = 0.f; }
#pragma unroll
    for (int ks = 0; ks < 8; ++ks) {
      bf16x8 k0 = *(const bf16x8*)(sK + (lr) * 136 + ks * 16 + lh * 8);
      bf16x8 k1 = *(const bf16x8*)(sK + (32 + lr) * 136 + ks * 16 + lh * 8);
      bf16x8 q0 = *(const bf16x8*)(sQ + (lr) * 136 + ks * 16 + lh * 8);
      bf16x8 q1 = *(const bf16x8*)(sQ + (32 + lr) * 136 + ks * 16 + lh * 8);
      X00 = __builtin_amdgcn_mfma_f32_32x32x16_bf16(k0, q0, X00, 0, 0, 0);
      X01 = __builtin_amdgcn_mfma_f32_32x32x16_bf16(k0, q1, X01, 0, 0, 0);
      X11 = __builtin_amdgcn_mfma_f32_32x32x16_bf16(k1, q1, X11, 0, 0, 0);
    }
    {
      const int dl = lr - 4 * lh;
#pragma unroll
      for (int e = 0; e < 16; ++e) {
        if (((e & 3) + 8 * (e >> 2)) > dl) { X00[e] = 0.f; X11[e] = 0.f; }
      }
    }
    __builtin_amdgcn_sched_barrier(0);
    f32x16 O0, O1;
#pragma unroll
    for (int e = 0; e < 16; ++e) { O0[e] = 0.f; O1[e] = 0.f; }
    const u16* vrow = sVT + (wave * 32 + lr) * 72;
#pragma unroll
    for (int s2 = 0; s2 < 2; ++s2) {
      bf16x8 a00, a01, a11;
#pragma unroll
      for (int j = 0; j < 8; ++j) {
        a00[j] = (short)f2bf(X00[8 * s2 + j]);
        a01[j] = (short)f2bf(X01[8 * s2 + j]);
        a11[j] = (short)f2bf(X11[8 * s2 + j]);
      }
      bf16x4 v0a = *(const bf16x4*)(vrow + 0 + 16 * s2 + 4 * lh);
      bf16x4 v0b = *(const bf16x4*)(vrow + 0 + 16 * s2 + 4 * lh + 8);
      bf16x4 v1a = *(const bf16x4*)(vrow + 32 + 16 * s2 + 4 * lh);
      bf16x4 v1b = *(const bf16x4*)(vrow + 32 + 16 * s2 + 4 * lh + 8);
      bf16x8 bv0 = {v0a[0], v0a[1], v0a[2], v0a[3], v0b[0], v0b[1], v0b[2], v0b[3]};
      bf16x8 bv1 = {v1a[0], v1a[1], v1a[2], v1a[3], v1b[0], v1b[1], v1b[2], v1b[3]};
      O0 = __builtin_amdgcn_mfma_f32_32x32x16_bf16(a00, bv0, O0, 0, 0, 0);
      O1 = __builtin_amdgcn_mfma_f32_32x32x16_bf16(a01, bv0, O1, 0, 0, 0);
      O1 = __builtin_amdgcn_mfma_f32_32x32x16_bf16(a11, bv1, O1, 0, 0, 0);
    }
    __builtin_amdgcn_sched_barrier(0);
#ifndef HG_NO_P2
#pragma unroll
    for (int db = 0; db < 4; ++db) {
#pragma unroll
      for (int s2 = 0; s2 < 2; ++s2) {
        bf16x8 bs;
#pragma unroll
        for (int j = 0; j < 8; ++j) bs[j] = (short)f2bf(S[db][8 * s2 + j]);
        const u16* q0p = sQ + (lr) * 136 + db * 32 + 16 * s2 + 4 * lh;
        const u16* q1p = sQ + (32 + lr) * 136 + db * 32 + 16 * s2 + 4 * lh;
        bf16x4 x0a = *(const bf16x4*)(q0p), x0b = *(const bf16x4*)(q0p + 8);
        bf16x4 x1a = *(const bf16x4*)(q1p), x1b = *(const bf16x4*)(q1p + 8);
        bf16x8 aq0 = {x0a[0], x0a[1], x0a[2], x0a[3], x0b[0], x0b[1], x0b[2], x0b[3]};
        bf16x8 aq1 = {x1a[0], x1a[1], x1a[2], x1a[3], x1b[0], x1b[1], x1b[2], x1b[3]};
        O0 = __builtin_amdgcn_mfma_f32_32x32x16_bf16(aq0, bs, O0, 0, 0, 0);
        O1 = __builtin_amdgcn_mfma_f32_32x32x16_bf16(aq1, bs, O1, 0, 0, 0);
      }
      __builtin_amdgcn_sched_barrier(0);
    }
#endif
    __builtin_amdgcn_sched_barrier(0);
#ifndef HG_NO_SU
#pragma unroll
    for (int db = 0; db < 4; ++db) {
#pragma unroll
      for (int ks = 0; ks < 4; ++ks) {
        bf16x8 ak = *(const bf16x8*)(sKT + (db * 32 + lr) * 72 + ks * 16 + lh * 8);
        bf16x8 bv = *(const bf16x8*)(vrow + ks * 16 + lh * 8);
        S[db] = __builtin_amdgcn_mfma_f32_32x32x16_bf16(ak, bv, S[db], 0, 0, 0);
      }
      {
        const float* dcp = sDecay + 4 * lh;
#pragma unroll
        for (int e = 0; e < 16; ++e) S[db][e] *= dcp[db * 32 + (e & 3) + 8 * (e >> 2)];
      }
      __builtin_amdgcn_sched_barrier(0);
    }
#endif
    __syncthreads();
    {
      float* ob = sO + (4 * lh) * 132 + wave * 32 + lr;
#pragma unroll
      for (int e = 0; e < 16; ++e) {
        ob[((e & 3) + 8 * (e >> 2)) * 132] = O0[e];
        ob[(32 + (e & 3) + 8 * (e >> 2)) * 132] = O1[e];
      }
    }
    __syncthreads();
#ifndef HG_NO_NORM
    {
      int tt = tid >> 2, qd = tid & 3;
      float ov[32];
      float ss = 0.f;
#pragma unroll
      for (int i = 0; i < 32; ++i) { ov[i] = sO[tt * 132 + qd * 32 + i]; ss += ov[i] * ov[i]; }
      ss += __shfl_xor(ss, 1);
      ss += __shfl_xor(ss, 2);
      float r = rsqrtf(ss * (1.f / 128.f) + 1e-6f);
      size_t tok = tokbase + t0 + tt;
      u16* op = p.mixin + tok * 1024 + 512 + h * 128 + qd * 32;
      const float* bog = p.b_out_g + qd * 32;
#define HG_OUT(GW, i_) { \
        const int vi = (i_) * 8; \
        unsigned o0_ = pack2(ov[vi + 0] * r * bog[vi + 0] * __uint_as_float(GW.x << 16), ov[vi + 1] * r * bog[vi + 1] * __uint_as_float(GW.x & 0xffff0000u)); \
        unsigned o1_ = pack2(ov[vi + 2] * r * bog[vi + 2] * __uint_as_float(GW.y << 16), ov[vi + 3] * r * bog[vi + 3] * __uint_as_float(GW.y & 0xffff0000u)); \
        unsigned o2_ = pack2(ov[vi + 4] * r * bog[vi + 4] * __uint_as_float(GW.z << 16), ov[vi + 5] * r * bog[vi + 5] * __uint_as_float(GW.z & 0xffff0000u)); \
        unsigned o3_ = pack2(ov[vi + 6] * r * bog[vi + 6] * __uint_as_float(GW.w << 16), ov[vi + 7] * r * bog[vi + 7] * __uint_as_float(GW.w & 0xffff0000u)); \
        *(uint4*)(op + vi) = make_uint4(o0_, o1_, o2_, o3_); }
      HG_OUT(gv0, 0) HG_OUT(gv1, 1) HG_OUT(gv2, 2) HG_OUT(gv3, 3)
#undef HG_OUT
    }
#endif
  }
}

__device__ void mixer0_phase(const Params& p, char* smem, int coff, int sub) {
  int* s_item = (int*)(smem + SMEM_BYTES - 16);
#ifndef NO_HGRN
#ifndef REPEAT_HGRN
#define REPEAT_HGRN 0
#endif
  if (sub & 1)
  for (;;) {
    int item = next_item(p.ctr + coff + 0, s_item);
    if (item >= 32) break;
    hgrn_item(p, item >> 2, item & 3, smem);
  }
#endif
#ifndef NO_DSA
#ifndef REPEAT_DSA
#define REPEAT_DSA 0
#endif
  if (sub & 2) {
    const int b = blockIdx.x & 7;
    int di = next_item(p.ctr + coff + 8 + b, s_item);
    while (di < 512) {
      unsigned nxt = 0u;
      if (threadIdx.x == 0) nxt = atomicAdd(p.ctr + coff + 8 + b, 1u);
      dsa_item(p, b, (511 - di) * 8, smem, sub);
      __syncthreads();
      if (threadIdx.x == 0) *s_item = (int)nxt;
      __syncthreads();
      di = *s_item;
    }
  }
#endif
}

__device__ __forceinline__ void swa_item(const Params& p, int b, int g, int qblk, char* smem) {
  u16* sVT = (u16*)smem;
  const int tid = threadIdx.x, lane = tid & 63, wave = __builtin_amdgcn_readfirstlane(tid >> 6);
  const int lr = lane & 31, lh = lane >> 5;
  const size_t tokbase = (size_t)b * SEQ;
  const int t0 = qblk * 32, kbase = t0 - 128;
  const int h = 4 * g + wave;
  __syncthreads();
#pragma unroll
  for (int i = 0; i < 5; ++i) {
    int cidx = tid + 256 * i;
    int key = cidx >> 3, dc = (cidx & 7) * 8;
    int j = kbase + key; j = j < 0 ? 0 : j;
    uint4 w = *(const uint4*)(p.dkv + (tokbase + j) * 256 + 128 + g * 64 + dc);
    unsigned ww[4] = {w.x, w.y, w.z, w.w};
    u16* dst = sVT + dc * 168 + key;
#pragma unroll
    for (int e = 0; e < 4; ++e) {
      dst[(2 * e) * 168] = (u16)(ww[e] & 0xffffu);
      dst[(2 * e + 1) * 168] = (u16)(ww[e] >> 16);
    }
  }
  bf16x8 qf[4];
  {
    const u16* qp = p.dq + (tokbase + t0 + lr) * 512 + h * 64 + 8 * lh;
#pragma unroll
    for (int ks = 0; ks < 4; ++ks) qf[ks] = *(const bf16x8*)(qp + ks * 16);
  }
  f32x16 S0, S1, S2, S3, S4;
#define SWA_QK(ST, kt_) { \
    int j = kbase + (kt_) * 32 + lr; j = j < 0 ? 0 : j; \
    const u16* kp = p.dkv + (tokbase + j) * 256 + g * 64 + 8 * lh; \
    bf16x8 k0 = *(const bf16x8*)(kp), k1 = *(const bf16x8*)(kp + 16), k2 = *(const bf16x8*)(kp + 32), k3 = *(const bf16x8*)(kp + 48); \
    _Pragma("unroll") for (int e = 0; e < 16; ++e) ST[e] = 0.f; \
    ST = __builtin_amdgcn_mfma_f32_32x32x16_bf16(k0, qf[0], ST, 0, 0, 0); \
    ST = __builtin_amdgcn_mfma_f32_32x32x16_bf16(k1, qf[1], ST, 0, 0, 0); \
    ST = __builtin_amdgcn_mfma_f32_32x32x16_bf16(k2, qf[2], ST, 0, 0, 0); \
    ST = __builtin_amdgcn_mfma_f32_32x32x16_bf16(k3, qf[3], ST, 0, 0, 0); }
  SWA_QK(S0, 0) SWA_QK(S1, 1) SWA_QK(S2, 2) SWA_QK(S3, 3) SWA_QK(S4, 4)
#undef SWA_QK
  const int tq = t0 + lr;
  float m = -INFINITY;
#define SWA_MASK(ST, kt_) { _Pragma("unroll") for (int e = 0; e < 16; ++e) { \
    int j = kbase + (kt_) * 32 + (e & 3) + 8 * (e >> 2) + 4 * lh; \
    bool ok = (j >= 0) && (j <= tq) && (j > tq - 128); \
    float v = ok ? ST[e] : -INFINITY; ST[e] = v; m = fmaxf(m, v); } }
  SWA_MASK(S0, 0) SWA_MASK(S1, 1) SWA_MASK(S2, 2) SWA_MASK(S3, 3) SWA_MASK(S4, 4)
#undef SWA_MASK
  m = fmaxf(m, __shfl_xor(m, 32));
  const float sk = p.d_sinks[h];
  m = fmaxf(m, sk);
  float sum = 0.f;
#define SWA_EXP(ST) { _Pragma("unroll") for (int e = 0; e < 16; ++e) { float pv = __expf(ST[e] - m); ST[e] = pv; sum += pv; } }
  SWA_EXP(S0) SWA_EXP(S1) SWA_EXP(S2) SWA_EXP(S3) SWA_EXP(S4)
#undef SWA_EXP
  sum += __shfl_xor(sum, 32);
  sum += __expf(sk - m);
  const float inv = 1.f / sum;
  __syncthreads();
  f32x16 O0, O1;
#pragma unroll
  for (int e = 0; e < 16; ++e) { O0[e] = 0.f; O1[e] = 0.f; }
#define SWA_PV(ST, kt_) { _Pragma("unroll") for (int s2 = 0; s2 < 2; ++s2) { \
    bf16x8 pb; \
    _Pragma("unroll") for (int j = 0; j < 8; ++j) pb[j] = (short)f2bf(ST[8 * s2 + j]); \
    const u16* v0p = sVT + lr * 168 + (kt_) * 32 + 16 * s2 + 4 * lh; \
    const u16* v1p = v0p + 32 * 168; \
    bf16x4 a0a = *(const bf16x4*)(v0p), a0b = *(const bf16x4*)(v0p + 8); \
    bf16x4 a1a = *(const bf16x4*)(v1p), a1b = *(const bf16x4*)(v1p + 8); \
    bf16x8 va0 = {a0a[0], a0a[1], a0a[2], a0a[3], a0b[0], a0b[1], a0b[2], a0b[3]}; \
    bf16x8 va1 = {a1a[0], a1a[1], a1a[2], a1a[3], a1b[0], a1b[1], a1b[2], a1b[3]}; \
    O0 = __builtin_amdgcn_mfma_f32_32x32x16_bf16(va0, pb, O0, 0, 0, 0); \
    O1 = __builtin_amdgcn_mfma_f32_32x32x16_bf16(va1, pb, O1, 0, 0, 0); } }
  SWA_PV(S0, 0) SWA_PV(S1, 1) SWA_PV(S2, 2) SWA_PV(S3, 3) SWA_PV(S4, 4)
#undef SWA_PV
  u16* op = p.mixin + (tokbase + tq) * 1024 + 512 + h * 64 + 4 * lh;
#pragma unroll
  for (int i = 0; i < 4; ++i) {
    *(uint2*)(op + 8 * i) = make_uint2(pack2(O0[4 * i] * inv, O0[4 * i + 1] * inv), pack2(O0[4 * i + 2] * inv, O0[4 * i + 3] * inv));
    *(uint2*)(op + 32 + 8 * i) = make_uint2(pack2(O1[4 * i] * inv, O1[4 * i + 1] * inv), pack2(O1[4 * i + 2] * inv, O1[4 * i + 3] * inv));
  }
}

__device__ void griffin_item(const Params& p, int b, int nb, int qq, char* smem) {
  float* sWr = (float*)smem;
  float* sWi = sWr + 1040;
  float* sCW = sWi + 1040;
  float* sCB = sCW + 256;
  float* sCst = sCB + 64;
  float* sAa = sCst + 48;
  float* sUu = sAa + 64 * 17;
  float* sSumA = sUu + 64 * 17;
  float* sSumH = sSumA + 256;
  float* sCarry = sSumH + 256;
  float* sG = sCarry + 16;
  float* sXo = sG + 64 * 33;
  u16* sXb = (u16*)(sXo + 64 * 17 + 4);
  const int tid = threadIdx.x, lane = tid & 63;
  const int wave = __builtin_amdgcn_readfirstlane(tid >> 6);
  const int lr = lane & 31, lh = lane >> 5;
  const int cgp = tid & 3, tl = tid >> 2;
  const size_t tokbase = (size_t)b * SEQ;
  const int cbase = nb * 64;
  const int obase = cbase + qq * 16;
  __syncthreads();
  sCW[tid] = p.c_conv_w[(tid >> 6) * 512 + cbase + (tid & 63)];
  if (tid < 64) sCB[tid] = p.c_conv_b[cbase + tid];
  if (tid < 16) {
    sCarry[tid] = 0.f;
    sCst[tid] = p.c_rg_b[obase + tid]; sCst[16 + tid] = p.c_ig_b[obase + tid];
    sCst[32 + tid] = log1pf(__expf(-p.c_lam[obase + tid]));
  }
  __syncthreads();
  u16* sWb = sXb + 64 * 72;
  {
    const int col = tid >> 3, ci0 = (tid & 7) * 8;
    const float* wsrc = ((col < 16) ? (p.c_rg_w + qq * 16 + col) : (p.c_ig_w + qq * 16 + (col - 16))) + (size_t)nb * 4096 + ci0 * 64;
    float w8[8];
#pragma unroll
    for (int j = 0; j < 8; ++j) w8[j] = wsrc[j * 64];
    *(uint4*)(sWb + col * 72 + ci0) = make_uint4(pack2(w8[0], w8[1]), pack2(w8[2], w8[3]), pack2(w8[4], w8[5]), pack2(w8[6], w8[7]));
  }
  __syncthreads();
  const int c = tid & 15, seg = tid >> 4;
  const float* cxp = p.cx + tokbase * 512 + cbase + cgp * 16;
  float4 nx[16];
#pragma unroll
  for (int i = 0; i < 16; ++i) nx[i] = make_float4(0.f, 0.f, 0.f, 0.f);
  for (int tile = -1; tile < 64; ++tile) {
    u16 ccg[4];
    if (tile >= 0) {
      int sg0 = seg, c0_ = c;
      asm volatile("" : "+v"(sg0), "+v"(c0_));
      const u16* cgt0 = p.cg + (tokbase + tile * 64 + sg0 * 4) * 512 + obase + c0_;
#pragma unroll
      for (int i = 0; i < 4; ++i) ccg[i] = cgt0[i * 512];
    } else {
#pragma unroll
      for (int i = 0; i < 4; ++i) ccg[i] = 0;
    }
    f32x16 xc;
#pragma unroll
    for (int j = 0; j < 4; ++j) {
      float4 acc4 = *(const float4*)(sCB + cgp * 16 + j * 4);
#pragma unroll
      for (int w = 0; w < 4; ++w) {
        float4 wv = *(const float4*)(sCW + w * 64 + cgp * 16 + j * 4);
        float4 xv = nx[w * 4 + j];
        acc4.x += xv.x * wv.x; acc4.y += xv.y * wv.y; acc4.z += xv.z * wv.z; acc4.w += xv.w * wv.w;
      }
      xc[j * 4] = acc4.x; xc[j * 4 + 1] = acc4.y; xc[j * 4 + 2] = acc4.z; xc[j * 4 + 3] = acc4.w;
    }
    __builtin_amdgcn_sched_barrier(0);
    if (tile + 1 < 64) {
      int tlo = tl, sgo = seg;
      asm volatile("" : "+v"(tlo), "+v"(sgo));
      const float* cpt = cxp + (size_t)((tile + 1) * 64 + tlo - 3) * 512;
      const bool first = (tile + 1 == 0);
#pragma unroll
      for (int w = 0; w < 4; ++w) {
        const bool ok = !first || (tlo - 3 + w >= 0);
#pragma unroll
        for (int j = 0; j < 4; ++j) nx[w * 4 + j] = ok ? *(const float4*)(cpt + w * 512 + j * 4) : make_float4(0.f, 0.f, 0.f, 0.f);
      }

    }
    __builtin_amdgcn_sched_barrier(0);
    if (tile < 0) continue;
    int tlv = tl, cgv = cgp;
    asm volatile("" : "+v"(tlv), "+v"(cgv));
    {
      u16* xb = sXb + tlv * 72 + cgv * 16;
      *(uint4*)(xb) = make_uint4(pack2(xc[0], xc[1]), pack2(xc[2], xc[3]), pack2(xc[4], xc[5]), pack2(xc[6], xc[7]));
      *(uint4*)(xb + 8) = make_uint4(pack2(xc[8], xc[9]), pack2(xc[10], xc[11]), pack2(xc[12], xc[13]), pack2(xc[14], xc[15]));
      if (cgp == qq) {
#pragma unroll
        for (int k = 0; k < 16; ++k) sXo[tlv * 17 + k] = xc[k];
      }
    }
    asm volatile("s_waitcnt lgkmcnt(0)" ::: "memory");
    {
      const int l15 = lane & 15, l4 = lane >> 4;
      const u16* ab = sXb + (wave * 16 + l15) * 72 + 8 * l4;
      const u16* wb = sWb + l15 * 72 + 8 * l4;
      f32x4 g0 = {0.f, 0.f, 0.f, 0.f}, g1 = {0.f, 0.f, 0.f, 0.f};
#pragma unroll
      for (int ks = 0; ks < 2; ++ks) {
        bf16x8 a = *(const bf16x8*)(ab + ks * 32);
        bf16x8 b0 = *(const bf16x8*)(wb + ks * 32);
        bf16x8 b1 = *(const bf16x8*)(wb + 16 * 72 + ks * 32);
        g0 = __builtin_amdgcn_mfma_f32_16x16x32_bf16(a, b0, g0, 0, 0, 0);
        g1 = __builtin_amdgcn_mfma_f32_16x16x32_bf16(a, b1, g1, 0, 0, 0);
      }
      float* gb = sG + (wave * 16 + 4 * l4) * 33 + l15;
#pragma unroll
      for (int j = 0; j < 4; ++j) { gb[j * 33] = g0[j]; gb[j * 33 + 16] = g1[j]; }
    }
    asm volatile("s_waitcnt lgkmcnt(0)" ::: "memory");
#pragma unroll
    for (int k = 0; k < 4; ++k) {
      int cc = cgv * 4 + k;
      float rp = sG[tlv * 33 + cc] + sCst[cc];
      float ip = sG[tlv * 33 + 16 + cc] + sCst[16 + cc];
      float r = __builtin_amdgcn_rcpf(1.f + __expf(-rp));
      float ig = __builtin_amdgcn_rcpf(1.f + __expf(-ip));
      float la = -8.f * r * sCst[32 + cc];
      float a = __expf(la);
      float u = __builtin_amdgcn_sqrtf(fmaxf(1.f - a * a, 0.f)) * (ig * sXo[tlv * 17 + cc]);
      sAa[tlv * 17 + cc] = a;
      sUu[tlv * 17 + cc] = u;
    }
    __syncthreads();
    float av[4], uv[4];
    {
      float A = 1.f, H = 0.f;
#pragma unroll
      for (int i = 0; i < 4; ++i) {
        av[i] = sAa[(seg * 4 + i) * 17 + c]; uv[i] = sUu[(seg * 4 + i) * 17 + c];
        H = av[i] * H + uv[i]; A *= av[i];
      }
      sSumA[seg * 16 + c] = A; sSumH[seg * 16 + c] = H;
    }
    __syncthreads();
    float hcur = sCarry[c];
    for (int s2 = 0; s2 < seg; ++s2) hcur = sSumA[s2 * 16 + c] * hcur + sSumH[s2 * 16 + c];
    __syncthreads();
    {
      int sg2 = seg, c2 = c;
      asm volatile("" : "+v"(sg2), "+v"(c2));
      u16* mo = p.mixin + (tokbase + tile * 64 + sg2 * 4) * 1024 + obase + c2;
#pragma unroll
      for (int i = 0; i < 4; ++i) {
        hcur = av[i] * hcur + uv[i];
        mo[i * 1024] = f2bf(bf2f(ccg[i]) * hcur);
      }
    }
    if (seg == 15) sCarry[c] = hcur;
  }
}

__device__ void mixer1_phase(const Params& p, char* smem, int coff, int sub) {
  int* s_item = (int*)(smem + SMEM_BYTES - 16);
  const int wave = __builtin_amdgcn_readfirstlane(threadIdx.x >> 6);
#ifndef NO_GRIFFIN
  if (sub & 1)
  for (;;) {
    int item = next_item(p.ctr + coff + 1, s_item);
    if (item >= 256) break;
    griffin_item(p, item >> 5, (item >> 2) & 7, item & 3, smem);
  }
#endif
#ifndef NO_SWA
  if (sub & 2) {
    const int b = blockIdx.x & 7;
    const size_t tokbase = (size_t)b * SEQ;
    int si = next_item(p.ctr + coff + 16 + b, s_item);
    while (si < 256) {
      unsigned nxt = 0u;
      if (threadIdx.x == 0) nxt = atomicAdd(p.ctr + coff + 16 + b, 1u);
      swa_item(p, b, si & 1, si >> 1, smem);
      __syncthreads();
      if (threadIdx.x == 0) *s_item = (int)nxt;
      __syncthreads();
      si = *s_item;
    }
  }
#endif
}

__device__ __forceinline__ void carve_ws(Params& p) {
  char* w = p.ws;
  size_t off = 0;
  auto take = [&](size_t bytes) { char* r = w + off; off += (bytes + 255) & ~(size_t)255; return r; };
  p.wt_in0 = (u16*)take((size_t)N_IN0 * 1024 * 2);
  p.wt_out0 = (u16*)take((size_t)1024 * 1024 * 2);
  p.wt_up0 = (u16*)take((size_t)4096 * 1024 * 2);
  p.wt_dn0 = (u16*)take((size_t)4096 * 1024 * 2);
  p.wt_in1 = (u16*)take((size_t)N_IN1 * 1024 * 2);
  p.wt_out1 = (u16*)take((size_t)1024 * 1024 * 2);
  p.wt_up1 = (u16*)take((size_t)4096 * 1024 * 2);
  p.wt_dn1 = (u16*)take((size_t)4096 * 1024 * 2);
  p.abuf = (u16*)take((size_t)T_TOK * 1024 * 2);
  p.mixin = (u16*)take((size_t)T_TOK * 1024 * 2);
  p.ss = (float*)take((size_t)4 * T_TOK * 4);
  p.rope = (float2*)take((size_t)T_TOK * 32 * 8);
  p.ctr = (unsigned*)take(256);
  char* big = take((size_t)T_TOK * 4096 * 2);
  p.hid = (u16*)big;
  {
    size_t o2 = 0;
    auto take2 = [&](size_t bytes) { char* r = big + o2; o2 += (bytes + 255) & ~(size_t)255; return r; };
    p.aq = (u16*)take2((size_t)T_TOK * 512 * 2);
    p.kv0 = (u16*)take2((size_t)T_TOK * 256 * 2);
    p.iq = (u16*)take2((size_t)T_TOK * 512 * 2);
    p.ik = (u16*)take2((size_t)T_TOK * 64 * 2);
    p.iw = (float*)take2((size_t)T_TOK * 8 * 4);
    p.bq = (u16*)take2((size_t)T_TOK * 512 * 2);
    p.blf = (float*)take2((size_t)T_TOK * 512 * 4);
    p.bi = (u16*)take2((size_t)T_TOK * 512 * 2);
    p.bg = (u16*)take2((size_t)T_TOK * 512 * 2);
  }
  {
    size_t o2 = 0;
    auto take2 = [&](size_t bytes) { char* r = big + o2; o2 += (bytes + 255) & ~(size_t)255; return r; };
    p.cg = (u16*)take2((size_t)T_TOK * 512 * 2);
    p.cx = (float*)take2((size_t)T_TOK * 512 * 4);
    p.dq = (u16*)take2((size_t)T_TOK * 512 * 2);
    p.dkv = (u16*)take2((size_t)T_TOK * 256 * 2);
  }
}

__global__ void __launch_bounds__(256, 2) mega_kernel(Params pin, int ph_lo, int ph_hi, int sub) {
  Params p = pin;
  carve_ws(p);
  __shared__ __attribute__((aligned(16))) char smem[SMEM_BYTES];
  GemmArgs ga;
#define PHASE_BEGIN(n) if (((PHASE_MASK >> n) & 1) && ph_lo <= n && n <= ph_hi) { if (n > ph_lo) cg::this_grid().sync();
#define PHASE_END }
  PHASE_BEGIN(0) for (int rep = 0; rep < 1 + (REPEAT_MASK & 1); ++rep) { if (rep) cg::this_grid().sync(); prep_phase(p, smem); } PHASE_END
  PHASE_BEGIN(1)
    ga = GemmArgs{p.abuf, p.wt_in0, 1024, N_IN0 / 128, p.ss, nullptr, nullptr, nullptr, nullptr, nullptr};
    for (int rep = 0; rep < 1 + ((REPEAT_MASK >> 1) & 1); ++rep) { if (rep) cg::this_grid().sync(); gemm_phase<EPI_IN0>(p, ga, smem); }
  PHASE_END
  PHASE_BEGIN(2) for (int rep = 0; rep < 1 + ((REPEAT_MASK >> 2) & 1); ++rep) { if (rep) cg::this_grid().sync(); mixer0_phase(p, smem, rep * 4, sub); } PHASE_END
  PHASE_BEGIN(3)
    ga = GemmArgs{p.mixin, p.wt_out0, 1024, 8, nullptr, p.x, p.out, p.norm_mlp_g, p.ss + T_TOK, p.abuf};
    gemm_phase<EPI_RES>(p, ga, smem);
  PHASE_END
  PHASE_BEGIN(4)
    ga = GemmArgs{p.abuf, p.wt_up0, 1024, 32, p.ss + T_TOK, nullptr, nullptr, nullptr, nullptr, nullptr};
    for (int rep = 0; rep < 1 + ((REPEAT_MASK >> 4) & 1); ++rep) { if (rep) cg::this_grid().sync(); gemm_phase<EPI_UP>(p, ga, smem); }
  PHASE_END
  PHASE_BEGIN(5)
    ga = GemmArgs{p.hid, p.wt_dn0, 4096, 8, nullptr, p.out, p.out, p.norm_mix_g + 1024, p.ss + 2 * T_TOK, p.abuf};
    gemm_phase<EPI_RES>(p, ga, smem);
  PHASE_END
  PHASE_BEGIN(6)
    ga = GemmArgs{p.abuf, p.wt_in1, 1024, N_IN1 / 128, p.ss + 2 * T_TOK, nullptr, nullptr, nullptr, nullptr, nullptr};
    gemm_phase<EPI_IN1>(p, ga, smem);
  PHASE_END
  PHASE_BEGIN(7) for (int rep = 0; rep < 1 + ((REPEAT_MASK >> 7) & 1); ++rep) { if (rep) cg::this_grid().sync(); mixer1_phase(p, smem, rep * 4, sub); } PHASE_END
  PHASE_BEGIN(8)
    ga = GemmArgs{p.mixin, p.wt_out1, 1024, 8, nullptr, p.out, p.out, p.norm_mlp_g + 1024, p.ss + 3 * T_TOK, p.abuf};
    gemm_phase<EPI_RES>(p, ga, smem);
  PHASE_END
  PHASE_BEGIN(9)
    ga = GemmArgs{p.abuf, p.wt_up1, 1024, 32, p.ss + 3 * T_TOK, nullptr, nullptr, nullptr, nullptr, nullptr};
    gemm_phase<EPI_UP>(p, ga, smem);
  PHASE_END
  PHASE_BEGIN(10)
    ga = GemmArgs{p.hid, p.wt_dn1, 4096, 8, nullptr, p.out, p.out, nullptr, nullptr, nullptr};
    gemm_phase<EPI_RES>(p, ga, smem);
  PHASE_END
}

extern "C" void kernel_launch(void* const* d_in, const int* in_sizes, int n_in, void* d_out, int out_size, void* d_ws,
                              size_t ws_size, hipStream_t stream) {
  Params p{};
  p.x = (const float*)d_in[0]; p.pos = (const int*)d_in[1];
  p.norm_mix_g = (const float*)d_in[2]; p.norm_mlp_g = (const float*)d_in[3];
  p.even_w_in = (const float*)d_in[4]; p.even_w_out = (const float*)d_in[5];
  p.a_q_g = (const float*)d_in[6]; p.a_k_g = (const float*)d_in[7];
  p.b_lb = (const float*)d_in[8]; p.b_out_g = (const float*)d_in[9];
  p.odd_w_in = (const float*)d_in[10]; p.odd_w_out = (const float*)d_in[11];
  p.c_conv_w = (const float*)d_in[12]; p.c_conv_b = (const float*)d_in[13];
  p.c_rg_w = (const float*)d_in[14]; p.c_rg_b = (const float*)d_in[15];
  p.c_ig_w = (const float*)d_in[16]; p.c_ig_b = (const float*)d_in[17];
  p.c_lam = (const float*)d_in[18]; p.d_q_g = (const float*)d_in[19]; p.d_k_g = (const float*)d_in[20];
  p.d_sinks = (const float*)d_in[21]; p.mlp_up = (const float*)d_in[22]; p.mlp_dn = (const float*)d_in[23];
  p.out = (float*)d_out;
  p.ws = (char*)d_ws;
  static int grid_blocks = 0;
  if (!grid_blocks) {
    int dev = 0, cus = 0, per_cu = 0;
    hipGetDevice(&dev);
    hipDeviceGetAttribute(&cus, hipDeviceAttributeMultiprocessorCount, dev);
    hipOccupancyMaxActiveBlocksPerMultiprocessor(&per_cu, mega_kernel, 256, 0);
    if (per_cu < 1) per_cu = 1;
    if (per_cu > 2) per_cu = 2;
    grid_blocks = cus * per_cu;
  }
#if MULTI_LAUNCH
  for (int ph = 0; ph < NPHASE; ++ph) {
    hipLaunchKernelGGL(mega_kernel, dim3(grid_blocks), dim3(256), 0, stream, p, ph, ph, 3);
  }
#else
  int lo = 0, hi = NPHASE - 1, sub3 = 3;
  void* args[] = {&p, &lo, &hi, &sub3};
  hipError_t e = hipLaunchCooperativeKernel((void*)mega_kernel, dim3(grid_blocks), dim3(256), args, 0, stream);
  if (e != hipSuccess) fprintf(stderr, "cooperative launch failed: %s (grid %d)\n", hipGetErrorString(e), grid_blocks);
  if (PROBE_PHASE >= 0) {
    int l2 = 0, h2 = 0;
    void* a2[] = {&p, &l2, &h2, &sub3};
    (void)hipLaunchCooperativeKernel((void*)mega_kernel, dim3(grid_blocks), dim3(256), a2, 0, stream);
    int l3 = PROBE_PHASE, h3 = PROBE_PHASE;
    int subp = PROBE_SUB;
    void* a3[] = {&p, &l3, &h3, &subp};
    if (PROBE_PHASE > 0) (void)hipLaunchCooperativeKernel((void*)mega_kernel, dim3(grid_blocks), dim3(256), a3, 0, stream);
  }
#endif
}
```

```cpp
#include <hip/hip_runtime.h>
#include <hip/hip_cooperative_groups.h>
#include <stdint.h>
#include <stdio.h>
namespace cg = cooperative_groups;

typedef unsigned short u16;
typedef __attribute__((ext_vector_type(8))) short bf16x8;
typedef __attribute__((ext_vector_type(4))) short bf16x4;
typedef __attribute__((ext_vector_type(16))) float f32x16;
typedef __attribute__((ext_vector_type(4))) float f32x4;
typedef __attribute__((ext_vector_type(8))) float f32x8;

#ifndef PHASE_MASK
#define PHASE_MASK 0x7ff
#endif
#ifndef REPEAT_MASK
#define REPEAT_MASK 0
#endif
#ifndef DSA_REP_A
#define DSA_REP_A 0
#endif
#ifndef DSA_REP_B
#define DSA_REP_B 0
#endif
#ifndef DSA_REP_C
#define DSA_REP_C 0
#endif
#ifndef PROBE_SUB
#define PROBE_SUB 3
#endif
#ifndef PROBE_PHASE
#define PROBE_PHASE -1
#endif
#ifndef MULTI_LAUNCH
#define MULTI_LAUNCH 0
#endif

static constexpr int T_TOK = 32768;
static constexpr int SEQ = 4096;
static constexpr int DM = 1024;
static constexpr int N_IN0 = 3456;
static constexpr int N_IN1 = 1792;
static constexpr int NPHASE = 11;
static constexpr int SMEM_BYTES = 73728;

struct Params {
  const float* x; const int* pos; const float* norm_mix_g; const float* norm_mlp_g;
  const float* even_w_in; const float* even_w_out; const float* a_q_g; const float* a_k_g;
  const float* b_lb; const float* b_out_g; const float* odd_w_in; const float* odd_w_out;
  const float* c_conv_w; const float* c_conv_b; const float* c_rg_w; const float* c_rg_b;
  const float* c_ig_w; const float* c_ig_b; const float* c_lam; const float* d_q_g; const float* d_k_g;
  const float* d_sinks; const float* mlp_up; const float* mlp_dn;
  float* out; char* ws;
  u16 *wt_in0, *wt_out0, *wt_up0, *wt_dn0, *wt_in1, *wt_out1, *wt_up1, *wt_dn1;
  u16 *abuf, *mixin; float* ss; float2* rope; unsigned* ctr;
  u16 *aq, *kv0, *iq, *ik; float* iw; u16* bq; float* blf; u16 *bi, *bg;
  u16* hid;
  u16* cg; float* cx; u16 *dq, *dkv;
};

__device__ __forceinline__ u16 f2bf(float f) {
  unsigned u = __float_as_uint(f);
  u += 0x7fffu + ((u >> 16) & 1u);
  return (u16)(u >> 16);
}
__device__ __forceinline__ float bf2f(u16 h) { return __uint_as_float(((unsigned)h) << 16); }
__device__ __forceinline__ unsigned pack2(float a, float b) { return (unsigned)f2bf(a) | ((unsigned)f2bf(b) << 16); }
__device__ __forceinline__ float sigmoidf_(float v) { return 1.f / (1.f + __expf(-v)); }
__device__ __forceinline__ float siluf_(float v) { return v * sigmoidf_(v); }
__device__ __forceinline__ float gelu_tanh(float v) {
  float u = 0.7978845608028654f * (v + 0.044715f * v * v * v);
  float th = 1.f - 2.f / (1.f + __expf(2.f * u));
  return 0.5f * v * (1.f + th);
}

__device__ __forceinline__ void store64_bf16(u16* dst, const float* v) {
#pragma unroll
  for (int i = 0; i < 8; ++i) {
    uint4 q;
    q.x = pack2(v[i * 8 + 0], v[i * 8 + 1]); q.y = pack2(v[i * 8 + 2], v[i * 8 + 3]);
    q.z = pack2(v[i * 8 + 4], v[i * 8 + 5]); q.w = pack2(v[i * 8 + 6], v[i * 8 + 7]);
    *(uint4*)(dst + i * 8) = q;
  }
}
__device__ __forceinline__ void store64_f32(float* dst, const float* v) {
#pragma unroll
  for (int i = 0; i < 16; ++i) *(float4*)(dst + i * 4) = make_float4(v[i * 4], v[i * 4 + 1], v[i * 4 + 2], v[i * 4 + 3]);
}
__device__ __forceinline__ void head_norm_rope(float* v, const float* g, const float2* rp, bool donorm, float scale) {
  if (donorm) {
    float ss = 0.f;
#pragma unroll
    for (int d = 0; d < 64; ++d) ss += v[d] * v[d];
    float r = rsqrtf(ss * (1.f / 64.f) + 1e-6f);
#pragma unroll
    for (int c = 0; c < 4; ++c) {
#pragma unroll
      for (int d = c * 16; d < c * 16 + 16; ++d) v[d] = v[d] * r * g[d];
      __builtin_amdgcn_sched_barrier(0);
    }
  }
#pragma unroll
  for (int c = 0; c < 4; ++c) {
#pragma unroll
    for (int d = c * 8; d < c * 8 + 8; ++d) {
      float2 cs = rp[d];
      float x1 = v[d], x2 = v[d + 32];
      v[d] = (x1 * cs.x - x2 * cs.y) * scale;
      v[d + 32] = (x2 * cs.x + x1 * cs.y) * scale;
    }
    __builtin_amdgcn_sched_barrier(0);
  }
}

__device__ __forceinline__ int next_item(unsigned* ctr, int* s_item) {
  __syncthreads();
  if (threadIdx.x == 0) *s_item = (int)atomicAdd(ctr, 1u);
  __syncthreads();
  return *s_item;
}

__device__ void prep_phase(const Params& p, char* smem) {
  const int tid = threadIdx.x;
  float* tile = (float*)smem;
  const int NT = 5920;
  const int NR = T_TOK / 4;
  for (int item = blockIdx.x; item < NT + NR; item += gridDim.x) {
    if (item < NT) {
      const float* src; u16* dst; int K, Nsrc, Ndst, base; int mode = 0;
      if (item < 864) { src = p.even_w_in; dst = p.wt_in0; K = 1024; Nsrc = 3400; Ndst = 3456; base = 0; mode = 1; }
      else if (item < 1120) { src = p.even_w_out; dst = p.wt_out0; K = 1024; Nsrc = 1024; Ndst = 1024; base = 864; }
      else if (item < 2144) { src = p.mlp_up; dst = p.wt_up0; K = 1024; Nsrc = 4096; Ndst = 4096; base = 1120; }
      else if (item < 3168) { src = p.mlp_dn; dst = p.wt_dn0; K = 4096; Nsrc = 1024; Ndst = 1024; base = 2144; }
      else if (item < 3616) { src = p.odd_w_in; dst = p.wt_in1; K = 1024; Nsrc = 1792; Ndst = 1792; base = 3168; }
      else if (item < 3872) { src = p.odd_w_out; dst = p.wt_out1; K = 1024; Nsrc = 1024; Ndst = 1024; base = 3616; }
      else if (item < 4896) { src = p.mlp_up + (size_t)1024 * 4096; dst = p.wt_up1; K = 1024; Nsrc = 4096; Ndst = 4096; base = 3872; }
      else { src = p.mlp_dn + (size_t)1024 * 4096; dst = p.wt_dn1; K = 4096; Nsrc = 1024; Ndst = 1024; base = 4896; }
      int li = item - base;
      int nk = K / 64;
      int n0 = (li / nk) * 64, k0 = (li % nk) * 64;
      __syncthreads();
#pragma unroll 4
      for (int i = 0; i < 16; ++i) {
        int k = i * 4 + (tid >> 6), n = tid & 63;
        int nd = n0 + n;
        int ns = nd;
        if (mode == 1) { ns = (nd < 1352) ? nd : ((nd < 1408) ? -1 : nd - 56); }
        float v = (ns >= 0) ? src[(size_t)(k0 + k) * Nsrc + ns] : 0.f;
        tile[k * 65 + n] = v;
      }
      __syncthreads();
#pragma unroll 4
      for (int i = 0; i < 8; ++i) {
        int n = i * 8 + (tid >> 5), k = (tid & 31) * 2;
        unsigned w = pack2(tile[k * 65 + n], tile[(k + 1) * 65 + n]);
        *(unsigned*)(dst + (size_t)(n0 + n) * K + k0 + k) = w;
      }
    } else {
      int rb = item - NT;
      if (rb == 0 && tid < 32) p.ctr[tid] = 0u;
      int t = rb * 4 + (tid >> 6);
      int lane = tid & 63;
      float ss = 0.f;
#pragma unroll
      for (int i = 0; i < 4; ++i) {
        int col = i * 256 + lane * 4;
        float4 xv = *(const float4*)(p.x + (size_t)t * DM + col);
        float4 gv = *(const float4*)(p.norm_mix_g + col);
        ss += xv.x * xv.x + xv.y * xv.y + xv.z * xv.z + xv.w * xv.w;
        uint2 w; w.x = pack2(xv.x * gv.x, xv.y * gv.y); w.y = pack2(xv.z * gv.z, xv.w * gv.w);
        *(uint2*)(p.abuf + (size_t)t * DM + col) = w;
      }
#pragma unroll
      for (int o = 32; o > 0; o >>= 1) ss += __shfl_xor(ss, o);
      if (lane == 0) {
        p.ss[t] = ss; p.ss[T_TOK + t] = 0.f; p.ss[2 * T_TOK + t] = 0.f; p.ss[3 * T_TOK + t] = 0.f;
      }
      if (lane < 32) {
        float invf = 1.0f / powf(10000.0f, (float)(2 * lane) / 64.0f);
        float ang = (float)p.pos[t] * invf;
        float s, c; sincosf(ang, &s, &c);
        p.rope[(size_t)t * 32 + lane] = make_float2(c, s);
      }
    }
  }
}

enum { EPI_IN0 = 0, EPI_RES = 1, EPI_UP = 2, EPI_IN1 = 3 };

struct GemmArgs {
  const u16* A; const u16* BT; int K; int ntn;
  const float* ssin;
  const float* xold; float* xnew; const float* gnext; float* ssout; u16* anext;
};

__device__ __forceinline__ void epi_rope(const float* rowp, float rstd, const float* g, const float2* rp, float scale, u16* dst) {
  float rn = rstd;
  if (g) {
    float ss = 0.f;
#pragma unroll 8
    for (int d = 0; d < 64; ++d) { float x = rowp[d] * rstd; ss += x * x; }
    rn = rstd * rsqrtf(ss * (1.f / 64.f) + 1e-6f);
  }
#pragma unroll
  for (int c = 0; c < 4; ++c) {
    f32x8 o1, o2;
#pragma unroll
    for (int e = 0; e < 8; ++e) {
      int d = c * 8 + e;
      float x1 = rowp[d] * rn, x2 = rowp[d + 32] * rn;
      if (g) { x1 *= g[d]; x2 *= g[d + 32]; }
      float2 cs = rp[d];
      o1[e] = (x1 * cs.x - x2 * cs.y) * scale;
      o2[e] = (x2 * cs.x + x1 * cs.y) * scale;
    }
    *(uint4*)(dst + c * 8) = make_uint4(pack2(o1[0], o1[1]), pack2(o1[2], o1[3]), pack2(o1[4], o1[5]), pack2(o1[6], o1[7]));
    *(uint4*)(dst + 32 + c * 8) = make_uint4(pack2(o2[0], o2[1]), pack2(o2[2], o2[3]), pack2(o2[4], o2[5]), pack2(o2[6], o2[7]));
    __builtin_amdgcn_sched_barrier(0);
  }
}
enum { F_ID = 0, F_SILU = 1, F_GELU = 2, F_RELU2 = 3 };
template <int F>
__device__ __forceinline__ float epi_fn(float x) {
  if (F == F_SILU) return siluf_(x);
  if (F == F_GELU) return gelu_tanh(x);
  if (F == F_RELU2) { float a = fmaxf(x, 0.f); return a * a; }
  return x;
}
template <int F>
__device__ __forceinline__ void epi_ew_bf16(const float* rowp, float rstd, u16* dst) {
#pragma unroll
  for (int c = 0; c < 4; ++c) {
    float o[16];
#pragma unroll
    for (int e = 0; e < 16; ++e) o[e] = epi_fn<F>(rowp[c * 16 + e] * rstd);
    *(uint4*)(dst + c * 16) = make_uint4(pack2(o[0], o[1]), pack2(o[2], o[3]), pack2(o[4], o[5]), pack2(o[6], o[7]));
    *(uint4*)(dst + c * 16 + 8) = make_uint4(pack2(o[8], o[9]), pack2(o[10], o[11]), pack2(o[12], o[13]), pack2(o[14], o[15]));
    __builtin_amdgcn_sched_barrier(0);
  }
}
__device__ __forceinline__ void epi_ew_f32(const float* rowp, float rstd, float* dst) {
#pragma unroll
  for (int c = 0; c < 4; ++c) {
#pragma unroll
    for (int e = 0; e < 4; ++e) {
      int d = c * 16 + e * 4;
      *(float4*)(dst + d) = make_float4(rowp[d] * rstd, rowp[d + 1] * rstd, rowp[d + 2] * rstd, rowp[d + 3] * rstd);
    }
    __builtin_amdgcn_sched_barrier(0);
  }
}

template <int EPI>
__device__ void gemm_epilogue(const Params& p, const GemmArgs& ga, const float* sC, int m0, int n0) {
  const int tid = threadIdx.x;
  const int r = tid >> 1, seg = tid & 1;
  const int t = m0 + r;
  const int gc = n0 + seg * 64;
  const float* rowp = sC + r * 132 + seg * 64;
  if (EPI == EPI_UP) {
    const int chunk = tid & 15, r16 = tid >> 4;
#pragma unroll
    for (int ps = 0; ps < 8; ++ps) {
      const int row = ps * 16 + r16;
      const int tt = m0 + row;
      const float rs = rsqrtf(ga.ssin[tt] * (1.f / 1024.f) + 1e-6f);
      const float* src = sC + row * 132 + chunk * 8;
      float o[8];
#pragma unroll
      for (int j = 0; j < 8; ++j) { float a = fmaxf(src[j] * rs, 0.f); o[j] = a * a; }
      *(uint4*)(p.hid + (size_t)tt * 4096 + n0 + chunk * 8) = make_uint4(pack2(o[0], o[1]), pack2(o[2], o[3]), pack2(o[4], o[5]), pack2(o[6], o[7]));
    }
    return;
  }
  if (EPI == EPI_RES) {
    const int c4 = tid & 31, r8 = tid >> 5;
    const int col = n0 + c4 * 4;
    float g0 = 0.f, g1 = 0.f, g2 = 0.f, g3 = 0.f;
    if (ga.gnext) { float4 gv = *(const float4*)(ga.gnext + col); g0 = gv.x; g1 = gv.y; g2 = gv.z; g3 = gv.w; }
#pragma unroll 4
    for (int ps = 0; ps < 16; ++ps) {
      const int row = ps * 8 + r8;
      const int tt = m0 + row;
      const float* src = sC + row * 132 + c4 * 4;
      float4 xv = *(const float4*)(ga.xold + (size_t)tt * DM + col);
      float o0 = xv.x + src[0], o1 = xv.y + src[1], o2 = xv.z + src[2], o3 = xv.w + src[3];
      *(float4*)(ga.xnew + (size_t)tt * DM + col) = make_float4(o0, o1, o2, o3);
      if (ga.gnext) {
        float ss = o0 * o0 + o1 * o1 + o2 * o2 + o3 * o3;
        *(uint2*)(ga.anext + (size_t)tt * DM + col) = make_uint2(pack2(o0 * g0, o1 * g1), pack2(o2 * g2, o3 * g3));
        ss += __shfl_xor(ss, 1); ss += __shfl_xor(ss, 2); ss += __shfl_xor(ss, 4); ss += __shfl_xor(ss, 8); ss += __shfl_xor(ss, 16);
        if (c4 == 0) atomicAdd(ga.ssout + tt, ss);
      }
    }
    return;
  }
  if (EPI == EPI_IN0 || EPI == EPI_IN1) {
    int fn = -1, ld = 0, cb = 0; u16* dstb = nullptr; float* dstf = nullptr;
    if (EPI == EPI_IN0) {
      if (n0 == 640) { fn = F_ID; dstb = p.kv0 + 128; ld = 256; cb = 640; }
      else if (n0 >= 1408 && n0 < 1920) { fn = F_SILU; dstb = p.bq; ld = 512; cb = 1408; }
      else if (n0 >= 1920 && n0 < 2432) { fn = 10; dstf = p.blf; ld = 512; cb = 1920; }
      else if (n0 >= 2432 && n0 < 2944) { fn = F_ID; dstb = p.bi; ld = 512; cb = 2432; }
      else if (n0 >= 2944) { fn = F_SILU; dstb = p.bg; ld = 512; cb = 2944; }
    } else {
      if (n0 < 512) { fn = F_GELU; dstb = p.cg; ld = 512; cb = 0; }
      else if (n0 < 1024) { fn = 11; dstf = p.cx; ld = 512; cb = 512; }
      else if (n0 == 1664) { fn = F_ID; dstb = p.dkv + 128; ld = 256; cb = 1664; }
    }
    {
      int rk = 0, rld = 0, rcb = 0; float rscale = 1.f; const float* rg = nullptr; u16* rdst = nullptr;
      if (EPI == EPI_IN0) {
        if (n0 < 512) { rk = 1; rg = p.a_q_g; rscale = 0.125f; rdst = p.aq; rld = 512; rcb = 0; }
        else if (n0 == 512) { rk = 1; rg = p.a_k_g; rdst = p.kv0; rld = 256; rcb = 512; }
        else if (n0 >= 768 && n0 < 1280) { rk = 1; rdst = p.iq; rld = 512; rcb = 768; }
      } else {
        if (n0 >= 1024 && n0 < 1536) { rk = 1; rg = p.d_q_g; rscale = 0.125f; rdst = p.dq; rld = 512; rcb = 1024; }
        else if (n0 == 1536) { rk = 1; rg = p.d_k_g; rdst = p.dkv; rld = 256; rcb = 1536; }
      }
      if (rk) {
        const int c = tid & 15, r16 = tid >> 4;
        const int hh = c >> 3, cc = c & 7;
        const float sgn = (cc < 4) ? -1.f : 1.f;
        const int dd0 = (cc & 3) * 8;
#pragma unroll 2
        for (int ps = 0; ps < 8; ++ps) {
          const int row = ps * 16 + r16;
          const int tt = m0 + row;
          const float rs = rsqrtf(ga.ssin[tt] * (1.f / 1024.f) + 1e-6f);
          const float* sm = sC + row * 132 + hh * 64 + cc * 8;
          const float* sp = sC + row * 132 + hh * 64 + (cc ^ 4) * 8;
          f32x8 mine, part;
          float ssq = 0.f;
#pragma unroll
          for (int j = 0; j < 8; ++j) { mine[j] = sm[j] * rs; part[j] = sp[j] * rs; ssq += mine[j] * mine[j]; }
          if (rg) {
            ssq += __shfl_xor(ssq, 1); ssq += __shfl_xor(ssq, 2); ssq += __shfl_xor(ssq, 4);
            const float rn = rsqrtf(ssq * (1.f / 64.f) + 1e-6f);
#pragma unroll
            for (int j = 0; j < 8; ++j) { mine[j] *= rn * rg[cc * 8 + j]; part[j] *= rn * rg[(cc ^ 4) * 8 + j]; }
          }
          const float2* rp2 = p.rope + (size_t)tt * 32 + dd0;
          f32x8 o;
#pragma unroll
          for (int j = 0; j < 8; ++j) {
            float2 cs = rp2[j];
            o[j] = (mine[j] * cs.x + sgn * part[j] * cs.y) * rscale;
          }
          *(uint4*)(rdst + (size_t)tt * rld + (n0 - rcb) + c * 8) = make_uint4(pack2(o[0], o[1]), pack2(o[2], o[3]), pack2(o[4], o[5]), pack2(o[6], o[7]));
        }
        return;
      }
    }
    if (fn >= 0 && fn < 10) {
      const int chunk = tid & 15, r16 = tid >> 4;
#pragma unroll 2
      for (int ps = 0; ps < 8; ++ps) {
        const int row = ps * 16 + r16;
        const int tt = m0 + row;
        const float rs = rsqrtf(ga.ssin[tt] * (1.f / 1024.f) + 1e-6f);
        const float* src = sC + row * 132 + chunk * 8;
        float o[8];
#pragma unroll
        for (int j = 0; j < 8; ++j) {
          float x = src[j] * rs;
          o[j] = (fn == F_SILU) ? siluf_(x) : ((fn == F_GELU) ? gelu_tanh(x) : x);
        }
        *(uint4*)(dstb + (size_t)tt * ld + (n0 - cb) + chunk * 8) = make_uint4(pack2(o[0], o[1]), pack2(o[2], o[3]), pack2(o[4], o[5]), pack2(o[6], o[7]));
      }
      return;
    }
    if (fn >= 10) {
      const int c4 = tid & 31, r8 = tid >> 5;
      const int cc = (n0 - cb) + c4 * 4;
      float lb0 = 0.f, lb1 = 0.f, lb2 = 0.f, lb3 = 0.f;
      if (fn == 10) {
        lb0 = sigmoidf_(p.b_lb[cc] - p.b_lb[512 + cc]); lb1 = sigmoidf_(p.b_lb[cc + 1] - p.b_lb[512 + cc + 1]);
        lb2 = sigmoidf_(p.b_lb[cc + 2] - p.b_lb[512 + cc + 2]); lb3 = sigmoidf_(p.b_lb[cc + 3] - p.b_lb[512 + cc + 3]);
      }
#pragma unroll 2
      for (int ps = 0; ps < 16; ++ps) {
        const int row = ps * 8 + r8;
        const int tt = m0 + row;
        const float rs = rsqrtf(ga.ssin[tt] * (1.f / 1024.f) + 1e-6f);
        const float* src = sC + row * 132 + c4 * 4;
        float o0 = src[0] * rs, o1 = src[1] * rs, o2 = src[2] * rs, o3 = src[3] * rs;
        if (fn == 10) {
          o0 = __logf(lb0 + (1.f - lb0) * sigmoidf_(o0)); o1 = __logf(lb1 + (1.f - lb1) * sigmoidf_(o1));
          o2 = __logf(lb2 + (1.f - lb2) * sigmoidf_(o2)); o3 = __logf(lb3 + (1.f - lb3) * sigmoidf_(o3));
        }
        *(float4*)(dstf + (size_t)tt * ld + cc) = make_float4(o0, o1, o2, o3);
      }
      return;
    }
  }
  const float rstd = rsqrtf(ga.ssin[t] * (1.f / 1024.f) + 1e-6f);

  const float2* rp = p.rope + (size_t)t * 32;
  if (EPI == EPI_IN0) {
    if (gc >= 1280 && gc < 1344) epi_rope(rowp, rstd, nullptr, rp, 1.f, p.ik + (size_t)t * 64);
    else if (gc >= 1344 && gc < 1408) {
      *(float4*)(p.iw + (size_t)t * 8) = make_float4(rowp[0] * rstd, rowp[1] * rstd, rowp[2] * rstd, rowp[3] * rstd);
      *(float4*)(p.iw + (size_t)t * 8 + 4) = make_float4(rowp[4] * rstd, rowp[5] * rstd, rowp[6] * rstd, rowp[7] * rstd);
    }
  }
}

#define G_LOAD(P, kt_) { \
  P##a0 = *(const uint4*)(Ag + (size_t)(0) * K + (kt_) * 64);  P##a1 = *(const uint4*)(Ag + (size_t)(32) * K + (kt_) * 64); \
  P##a2 = *(const uint4*)(Ag + (size_t)(64) * K + (kt_) * 64); P##a3 = *(const uint4*)(Ag + (size_t)(96) * K + (kt_) * 64); \
  P##b0 = *(const uint4*)(Bg + (size_t)(0) * K + (kt_) * 64);  P##b1 = *(const uint4*)(Bg + (size_t)(32) * K + (kt_) * 64); \
  P##b2 = *(const uint4*)(Bg + (size_t)(64) * K + (kt_) * 64); P##b3 = *(const uint4*)(Bg + (size_t)(96) * K + (kt_) * 64); }
#define S_STORE(P, buf_) { \
  *(uint4*)(sAw + (buf_) * 128 * 72 + 0 * 72) = P##a0;  *(uint4*)(sAw + (buf_) * 128 * 72 + 32 * 72) = P##a1; \
  *(uint4*)(sAw + (buf_) * 128 * 72 + 64 * 72) = P##a2; *(uint4*)(sAw + (buf_) * 128 * 72 + 96 * 72) = P##a3; \
  *(uint4*)(sBw + (buf_) * 128 * 72 + 0 * 72) = P##b0;  *(uint4*)(sBw + (buf_) * 128 * 72 + 32 * 72) = P##b1; \
  *(uint4*)(sBw + (buf_) * 128 * 72 + 64 * 72) = P##b2; *(uint4*)(sBw + (buf_) * 128 * 72 + 96 * 72) = P##b3; }
__device__ __forceinline__ void mma_tile(f32x16& acc00, f32x16& acc01, f32x16& acc10, f32x16& acc11, const u16* sA, const u16* sB, int buf, int wm, int wn, int lr, int lh) {
  const u16* a_base = sA + buf * 128 * 72 + (wm * 64 + lr) * 72 + lh * 8;
  const u16* b_base = sB + buf * 128 * 72 + (wn * 64 + lr) * 72 + lh * 8;
#pragma unroll
  for (int ks = 0; ks < 4; ++ks) {
    bf16x8 a0 = *(const bf16x8*)(a_base + ks * 16);
    bf16x8 a1 = *(const bf16x8*)(a_base + 32 * 72 + ks * 16);
    bf16x8 b0 = *(const bf16x8*)(b_base + ks * 16);
    bf16x8 b1 = *(const bf16x8*)(b_base + 32 * 72 + ks * 16);
    acc00 = __builtin_amdgcn_mfma_f32_32x32x16_bf16(a0, b0, acc00, 0, 0, 0);
    acc01 = __builtin_amdgcn_mfma_f32_32x32x16_bf16(a0, b1, acc01, 0, 0, 0);
    acc10 = __builtin_amdgcn_mfma_f32_32x32x16_bf16(a1, b0, acc10, 0, 0, 0);
    acc11 = __builtin_amdgcn_mfma_f32_32x32x16_bf16(a1, b1, acc11, 0, 0, 0);
  }
}

template <int EPI>
__device__ void gemm_phase(const Params& p, const GemmArgs& ga, char* smem) {
  const int tid = threadIdx.x, lane = tid & 63, wave = __builtin_amdgcn_readfirstlane(tid >> 6);
  const int wm = wave >> 1, wn = wave & 1;
  const int lr = lane & 31, lh = lane >> 5;
  const int K = ga.K;
  const int nk = K / 64;
  u16* sA = (u16*)smem;
  u16* sB = (u16*)(smem + 2 * 128 * 72 * 2);
  float* sC = (float*)smem;
  const int xcd = blockIdx.x & 7, slot = blockIdx.x >> 3, nslot = gridDim.x >> 3;
  const int nlocal = 32 * ga.ntn;
  for (int lt = slot; lt < nlocal; lt += nslot) {
    const int pp = lt & 7, rest = lt >> 3;
    const int tn = rest % ga.ntn, pg = rest / ga.ntn;
    const int tm = (pg * 8 + pp) * 8 + xcd;
    const int m0 = tm * 128, n0 = tn * 128;
    const u16* Ap = ga.A + (size_t)m0 * K;
    const u16* Bp = ga.BT + (size_t)n0 * K;
    f32x16 acc00, acc01, acc10, acc11;
#pragma unroll
    for (int e = 0; e < 16; ++e) { acc00[e] = 0.f; acc01[e] = 0.f; acc10[e] = 0.f; acc11[e] = 0.f; }
    const int srow = tid >> 3, scol = (tid & 7) * 8;
    const u16* Ag = Ap + (size_t)srow * K + scol;
    const u16* Bg = Bp + (size_t)srow * K + scol;
    u16* sAw = sA + srow * 72 + scol;
    u16* sBw = sB + srow * 72 + scol;
    uint4 p0a0, p0a1, p0a2, p0a3, p0b0, p0b1, p0b2, p0b3, p1a0, p1a1, p1a2, p1a3, p1b0, p1b1, p1b2, p1b3;
    G_LOAD(p0, 0)
    G_LOAD(p1, 1)
    S_STORE(p0, 0)
    __syncthreads();
    for (int kt = 0; kt < nk; kt += 2) {
      if (kt + 2 < nk) G_LOAD(p0, kt + 2)
      __builtin_amdgcn_sched_barrier(0);
      mma_tile(acc00, acc01, acc10, acc11, sA, sB, 0, wm, wn, lr, lh);
      S_STORE(p1, 1)
      __syncthreads();
      if (kt + 3 < nk) G_LOAD(p1, kt + 3)
      __builtin_amdgcn_sched_barrier(0);
      mma_tile(acc00, acc01, acc10, acc11, sA, sB, 1, wm, wn, lr, lh);
      if (kt + 2 < nk) S_STORE(p0, 0)
      __syncthreads();
    }
    {
      float* cb = sC + (wm * 64 + 4 * lh) * 132 + wn * 64 + lr;
#pragma unroll
      for (int e = 0; e < 16; ++e) {
        cb[((e & 3) + 8 * (e >> 2)) * 132] = acc00[e];
        cb[((e & 3) + 8 * (e >> 2)) * 132 + 32] = acc01[e];
        cb[(32 + (e & 3) + 8 * (e >> 2)) * 132] = acc10[e];
        cb[(32 + (e & 3) + 8 * (e >> 2)) * 132 + 32] = acc11[e];
      }
    }
    __syncthreads();
    gemm_epilogue<EPI>(p, ga, sC, m0, n0);
    __syncthreads();
  }
}

__device__ void attend_wave(const u16* Qb, const u16* KV, size_t tokbase, int tq, const u16* sel, int first_key, int nsel,
                            const float* sinks, float* sP, u16* outp) {
  const int lane = threadIdx.x & 63;
  const int n = lane & 15, G = lane >> 4;
  bf16x8 bq[4];
#pragma unroll
  for (int ks = 0; ks < 4; ++ks) {
    int kdim = ks * 32 + 8 * G;
    int kg = kdim >> 6, d0 = kdim & 63;
    bf16x8 z = {0, 0, 0, 0, 0, 0, 0, 0};
    if (n < 8 && (n >> 2) == kg) z = *(const bf16x8*)(Qb + (tokbase + tq) * 512 + n * 64 + d0);
    bq[ks] = z;
  }
  const int ntile = (nsel + 15) >> 4;
  bf16x8 ka0, ka1, ka2, ka3, kb0, kb1, kb2, kb3, kc0, kc1, kc2, kc3, kd0, kd1, kd2, kd3;
  float mx = -INFINITY;
#define QK_GATHER(A0, A1, A2, A3, ti_) { int slot = (ti_) * 16 + n; slot = slot < nsel ? slot : nsel - 1; \
    int idx = (int)sel[slot]; const u16* kr = KV + (tokbase + idx) * 256 + 8 * G; \
    A0 = *(const bf16x8*)(kr); A1 = *(const bf16x8*)(kr + 32); A2 = *(const bf16x8*)(kr + 64); A3 = *(const bf16x8*)(kr + 96); }
#define QK_USE(A0, A1, A2, A3, ti_) { f32x4 c = {0.f, 0.f, 0.f, 0.f}; \
    c = __builtin_amdgcn_mfma_f32_16x16x32_bf16(A0, bq[0], c, 0, 0, 0); \
    c = __builtin_amdgcn_mfma_f32_16x16x32_bf16(A1, bq[1], c, 0, 0, 0); \
    c = __builtin_amdgcn_mfma_f32_16x16x32_bf16(A2, bq[2], c, 0, 0, 0); \
    c = __builtin_amdgcn_mfma_f32_16x16x32_bf16(A3, bq[3], c, 0, 0, 0); \
    mx = fmaxf(mx, fmaxf(fmaxf(c[0], c[1]), fmaxf(c[2], c[3]))); \
    if (n < 8) { float* dp = sP + ((ti_) * 16 + 4 * G) * 8 + n; dp[0] = c[0]; dp[8] = c[1]; dp[16] = c[2]; dp[24] = c[3]; } }
  QK_GATHER(ka0, ka1, ka2, ka3, 0)
  QK_GATHER(kb0, kb1, kb2, kb3, 1)
  QK_GATHER(kc0, kc1, kc2, kc3, 2)
  QK_GATHER(kd0, kd1, kd2, kd3, 3)
  for (int ti0 = 0; ti0 < ntile; ti0 += 4) {
    bf16x8 ca0 = ka0, ca1 = ka1, ca2 = ka2, ca3 = ka3, cb0 = kb0, cb1 = kb1, cb2 = kb2, cb3 = kb3;
    bf16x8 cc0 = kc0, cc1 = kc1, cc2 = kc2, cc3 = kc3, cd0 = kd0, cd1 = kd1, cd2 = kd2, cd3 = kd3;
    if (ti0 + 4 < ntile) {
      QK_GATHER(ka0, ka1, ka2, ka3, ti0 + 4)
      QK_GATHER(kb0, kb1, kb2, kb3, ti0 + 5)
      QK_GATHER(kc0, kc1, kc2, kc3, ti0 + 6)
      QK_GATHER(kd0, kd1, kd2, kd3, ti0 + 7)
    }
    QK_USE(ca0, ca1, ca2, ca3, ti0)
    if (ti0 + 1 < ntile) QK_USE(cb0, cb1, cb2, cb3, ti0 + 1)
    if (ti0 + 2 < ntile) QK_USE(cc0, cc1, cc2, cc3, ti0 + 2)
    if (ti0 + 3 < ntile) QK_USE(cd0, cd1, cd2, cd3, ti0 + 3)
  }
#undef QK_GATHER
#undef QK_USE
  __builtin_amdgcn_wave_barrier();
  const int hh = lane & 7, sg = lane >> 3;
  mx = fmaxf(mx, __shfl_xor(mx, 16));
  mx = fmaxf(mx, __shfl_xor(mx, 32));
  float m = __shfl(mx, hh);
  float sk = 0.f;
  if (sinks) { sk = sinks[hh]; m = fmaxf(m, sk); }
  float sum = 0.f;
  for (int sl_ = sg; sl_ < nsel; sl_ += 8) {
    float e = __expf(sP[sl_ * 8 + hh] - m);
    sP[sl_ * 8 + hh] = e; sum += e;
  }
  sum += __shfl_xor(sum, 8);
  sum += __shfl_xor(sum, 16);
  sum += __shfl_xor(sum, 32);
  if (sinks) sum += __expf(sk - m);
  const float inv = 1.f / sum;
  __builtin_amdgcn_wave_barrier();
  const int kq = lane >> 4, c = lane & 15;
  const int g = c >> 3;
  f32x8 o0 = {0.f, 0.f, 0.f, 0.f, 0.f, 0.f, 0.f, 0.f}, o1 = o0, o2 = o0, o3 = o0;
  const u16* vbase = KV + tokbase * 256 + 128 + 8 * c;
  const int ngrp = (nsel + 3) >> 2;
  uint4 vq0, vq1, vq2, vq3, vq4, vq5, vq6, vq7;
#define PV_GATHER(V, it_) { int s_ = (it_) * 4 + kq; s_ = s_ < nsel ? s_ : nsel - 1; \
    int idx = (int)sel[s_]; V = *(const uint4*)(vbase + (size_t)idx * 256); }
#define PV_USE(V, it_) { int s_ = (it_) * 4 + kq; bool valid = s_ < nsel; int sc_ = valid ? s_ : nsel - 1; \
    float4 pp = *(const float4*)(sP + sc_ * 8 + 4 * g); if (!valid) pp = make_float4(0.f, 0.f, 0.f, 0.f); \
    f32x8 ve; \
    ve[0] = __uint_as_float(V.x << 16); ve[1] = __uint_as_float(V.x & 0xffff0000u); \
    ve[2] = __uint_as_float(V.y << 16); ve[3] = __uint_as_float(V.y & 0xffff0000u); \
    ve[4] = __uint_as_float(V.z << 16); ve[5] = __uint_as_float(V.z & 0xffff0000u); \
    ve[6] = __uint_as_float(V.w << 16); ve[7] = __uint_as_float(V.w & 0xffff0000u); \
    o0 += pp.x * ve; o1 += pp.y * ve; o2 += pp.z * ve; o3 += pp.w * ve; }
  PV_GATHER(vq0, 0) PV_GATHER(vq1, 1) PV_GATHER(vq2, 2) PV_GATHER(vq3, 3)
  PV_GATHER(vq4, 4) PV_GATHER(vq5, 5) PV_GATHER(vq6, 6) PV_GATHER(vq7, 7)
  for (int it0 = 0; it0 < ngrp; it0 += 8) {
    uint4 c0 = vq0, c1 = vq1, c2 = vq2, c3 = vq3, c4 = vq4, c5 = vq5, c6 = vq6, c7 = vq7;
    if (it0 + 8 < ngrp) {
      PV_GATHER(vq0, it0 + 8) PV_GATHER(vq1, it0 + 9) PV_GATHER(vq2, it0 + 10) PV_GATHER(vq3, it0 + 11)
      PV_GATHER(vq4, it0 + 12) PV_GATHER(vq5, it0 + 13) PV_GATHER(vq6, it0 + 14) PV_GATHER(vq7, it0 + 15)
    }
    PV_USE(c0, it0) PV_USE(c1, it0 + 1) PV_USE(c2, it0 + 2) PV_USE(c3, it0 + 3)
    PV_USE(c4, it0 + 4) PV_USE(c5, it0 + 5) PV_USE(c6, it0 + 6) PV_USE(c7, it0 + 7)
  }
#undef PV_GATHER
#undef PV_USE
#pragma unroll
  for (int e = 0; e < 8; ++e) {
    float v;
    v = o0[e]; v += __shfl_xor(v, 16); v += __shfl_xor(v, 32); o0[e] = v;
    v = o1[e]; v += __shfl_xor(v, 16); v += __shfl_xor(v, 32); o1[e] = v;
    v = o2[e]; v += __shfl_xor(v, 16); v += __shfl_xor(v, 32); o2[e] = v;
    v = o3[e]; v += __shfl_xor(v, 16); v += __shfl_xor(v, 32); o3[e] = v;
  }
  float iv = __shfl(inv, 4 * g + kq);
  f32x8 r8 = o0;
  r8 = (kq == 1) ? o1 : r8;
  r8 = (kq == 2) ? o2 : r8;
  r8 = (kq == 3) ? o3 : r8;
  r8 *= iv;
  *(uint4*)(outp + (4 * g + kq) * 64 + ((8 * c) & 63)) = make_uint4(pack2(r8[0], r8[1]), pack2(r8[2], r8[3]), pack2(r8[4], r8[5]), pack2(r8[6], r8[7]));
}

__device__ __noinline__ void dsa_select_unused(int); __device__ __forceinline__ void dsa_select(const u16* sc, unsigned* hs, u16* sl, int n, int target, int lane) {
  const int niter = (n + 63) >> 6;
  unsigned prefix = 0u;
  int need = target;
  for (int pass = 0; pass < 2; ++pass) {
    hs[lane] = 0u; hs[lane + 64] = 0u; hs[lane + 128] = 0u; hs[lane + 192] = 0u;
    asm volatile("s_waitcnt lgkmcnt(0)" ::: "memory");
#pragma unroll 2
    for (int i = 0; i < niter; ++i) {
      int key = i * 64 + lane;
      unsigned v = sc[key];
      bool act = (key < n) && (pass == 0 || (v >> 8) == prefix);
      unsigned bin = pass == 0 ? (v >> 8) : (v & 255u);
      if (act) atomicAdd(&hs[bin], 1u);
    }
    asm volatile("s_waitcnt lgkmcnt(0)" ::: "memory");
    uint4 cv = *(const uint4*)(hs + 4 * lane);
    int c0 = cv.x, c1 = cv.y, c2 = cv.z, c3 = cv.w;
    int sl4 = c0 + c1 + c2 + c3;
    int incl = sl4;
#pragma unroll
    for (int o = 1; o < 64; o <<= 1) {
      int tv = __shfl_down(incl, o);
      if (lane + o < 64) incl += tv;
    }
    int excl = incl - sl4;
    bool mine = (excl < need) && (need <= incl);
    int bsel = 0, above = excl;
    if (mine) {
      if (above + c3 >= need) bsel = 3;
      else { above += c3; if (above + c2 >= need) bsel = 2; else { above += c2; if (above + c1 >= need) bsel = 1; else { above += c1; bsel = 0; } } }
    }
    unsigned long long bm = __ballot(mine);
    int src = __ffsll((long long)bm) - 1;
    int binfull = __shfl(4 * lane + bsel, src);
    int abovefull = __shfl(above, src);
    prefix = (pass == 0) ? (unsigned)binfull : ((prefix << 8) | (unsigned)binfull);
    need -= abovefull;
    asm volatile("s_waitcnt lgkmcnt(0)" ::: "memory");
  }
  const unsigned Tthr = prefix;
  const int cgt = target - need;
  int posg = 0, post = 0;
  const unsigned long long lt = (1ull << lane) - 1ull;
#pragma unroll 4
  for (int i = 0; i < niter; ++i) {
    int key = i * 64 + lane;
    unsigned v = sc[key];
    bool inr = key < n;
    bool isg = inr && (v > Tthr);
    bool ist = inr && (v == Tthr);
    unsigned long long bg = __ballot(isg), bt = __ballot(ist);
    int rg = posg + __popcll(bg & lt);
    int rt = post + __popcll(bt & lt);
    if (isg) sl[rg] = (u16)key;
    if (ist && rt < need) sl[cgt + rt] = (u16)key;
    posg += __popcll(bg); post += __popcll(bt);
  }
}

__device__ void dsa_item(const Params& p, int b, int q0, char* smem, int sub) {
  u16* score16 = (u16*)smem;
  unsigned* hist = (unsigned*)(smem + 65536);
  u16* selL = (u16*)(smem + 65536 + 4096);
  const int tid = threadIdx.x, lane = tid & 63, wave = __builtin_amdgcn_readfirstlane(tid >> 6);
  const int lr = lane & 31, lh = lane >> 5;
  const size_t tokbase = (size_t)b * SEQ;
  const int nkeys = q0 + 8;
  const int ntile = (nkeys + 31) >> 5;
  if (!(sub & 4)) {
    const int m = lr;
    const int i_ = m >> 3, gg = (m >> 2) & 1, j_ = m & 3;
    const int qq = 2 * gg + (i_ >> 1), hh = (i_ & 1) * 4 + j_;
    const u16* ap0 = p.iq + (tokbase + q0 + qq) * 512 + hh * 64 + lh * 8;
    const u16* ap1 = ap0 + 4 * 512;
    bf16x8 a00 = *(const bf16x8*)(ap0), a01 = *(const bf16x8*)(ap0 + 16), a02 = *(const bf16x8*)(ap0 + 32), a03 = *(const bf16x8*)(ap0 + 48);
    bf16x8 a10 = *(const bf16x8*)(ap1), a11 = *(const bf16x8*)(ap1 + 16), a12 = *(const bf16x8*)(ap1 + 32), a13 = *(const bf16x8*)(ap1 + 48);
    f32x16 w0, w1;
#pragma unroll
    for (int r = 0; r < 16; ++r) {
      w0[r] = p.iw[(tokbase + q0 + 2 * lh + (r >> 3)) * 8 + (r & 7)];
      w1[r] = p.iw[(tokbase + q0 + 4 + 2 * lh + (r >> 3)) * 8 + (r & 7)];
    }
    const u16* ikb = p.ik + tokbase * 64 + lr * 64 + lh * 8;
    bf16x8 n0, n1, n2, n3;
    if (wave < ntile) {
      const u16* bp = ikb + (size_t)wave * 32 * 64;
      n0 = *(const bf16x8*)(bp); n1 = *(const bf16x8*)(bp + 16); n2 = *(const bf16x8*)(bp + 32); n3 = *(const bf16x8*)(bp + 48);
    }
    for (int kt = wave; kt < ntile; kt += 4) {
      int key = kt * 32 + lr;
      bf16x8 b0 = n0, b1 = n1, b2 = n2, b3 = n3;
      if (kt + 4 < ntile) {
        const u16* bp = ikb + (size_t)(kt + 4) * 32 * 64;
        n0 = *(const bf16x8*)(bp); n1 = *(const bf16x8*)(bp + 16); n2 = *(const bf16x8*)(bp + 32); n3 = *(const bf16x8*)(bp + 48);
      }
      f32x16 c0, c1;
#pragma unroll
      for (int e = 0; e < 16; ++e) { c0[e] = 0.f; c1[e] = 0.f; }
      c0 = __builtin_amdgcn_mfma_f32_32x32x16_bf16(a00, b0, c0, 0, 0, 0);
      c1 = __builtin_amdgcn_mfma_f32_32x32x16_bf16(a10, b0, c1, 0, 0, 0);
      c0 = __builtin_amdgcn_mfma_f32_32x32x16_bf16(a01, b1, c0, 0, 0, 0);
      c1 = __builtin_amdgcn_mfma_f32_32x32x16_bf16(a11, b1, c1, 0, 0, 0);
      c0 = __builtin_amdgcn_mfma_f32_32x32x16_bf16(a02, b2, c0, 0, 0, 0);
      c1 = __builtin_amdgcn_mfma_f32_32x32x16_bf16(a12, b2, c1, 0, 0, 0);
      c0 = __builtin_amdgcn_mfma_f32_32x32x16_bf16(a03, b3, c0, 0, 0, 0);
      c1 = __builtin_amdgcn_mfma_f32_32x32x16_bf16(a13, b3, c1, 0, 0, 0);
      float s0 = 0.f, s1 = 0.f, s2 = 0.f, s3 = 0.f;
#pragma unroll
      for (int r = 0; r < 8; ++r) {
        s0 += fmaxf(c0[r], 0.f) * w0[r]; s1 += fmaxf(c0[8 + r], 0.f) * w0[8 + r];
        s2 += fmaxf(c1[r], 0.f) * w1[r]; s3 += fmaxf(c1[8 + r], 0.f) * w1[8 + r];
      }
      f32x4 sv = {s0, s1, s2, s3};
#pragma unroll
      for (int k = 0; k < 4; ++k) {
        float sf = sv[k] + 0.f;
        unsigned u = __float_as_uint(sf);
        unsigned ua = u & 0x7fffffffu;
        int mag = (int)(ua >> 13) - ((127 - 20) << 10);
        mag = mag < 0 ? 0 : (mag > 0x7fff ? 0x7fff : mag);
        unsigned k16 = (u & 0x80000000u) ? (unsigned)(0x7fff - mag) : (0x8000u | (unsigned)mag);
        k16 = k16 < 1u ? 1u : k16;
        int ql = (k >> 1) * 4 + 2 * lh + (k & 1);
        unsigned v16 = (key > q0 + ql) ? 0u : k16;
        score16[ql * 4096 + key] = (u16)v16;
      }
    }
  }
  __syncthreads();
#pragma unroll 1
  for (int rep = 0; rep < 2; ++rep) {
    const int ql = wave + 4 * rep;
    const int q = q0 + ql;
    const int n = q + 1;
    const int target = n < 256 ? n : 256;
    if (!(sub & 4)) dsa_select(score16 + ql * 4096, hist + wave * 256, selL + ql * 256, n, target, lane);
  }
  __syncthreads();
#pragma unroll 1
  for (int rep = 0; rep < 2; ++rep) {
    const int ql = wave + 4 * rep;
    const int q = q0 + ql;
    const int n = q + 1;
    const int target = n < 256 ? n : 256;
    if (!(sub & 8))
      attend_wave(p.aq, p.kv0, tokbase, q, selL + ql * 256, 0, target, nullptr, (float*)(score16 + wave * 4096), p.mixin + (tokbase + q) * 1024);
  }
}

__device__ void hgrn_item(const Params& p, int b, int h, char* smem) {
  u16* sQ = (u16*)smem;
  u16* sK = (u16*)(smem + 17408);
  u16* sKT = (u16*)(smem + 34816);
  u16* sVT = (u16*)(smem + 34816 + 18432);
  float* sDecay = (float*)(smem + 71680);
  float* sTot = (float*)(smem + 71680 + 512);
  float* sO = (float*)smem;
  const int tid = threadIdx.x, lane = tid & 63, wave = __builtin_amdgcn_readfirstlane(tid >> 6);
  const int lr = lane & 31, lh = lane >> 5;
  const size_t tokbase = (size_t)b * SEQ;
  f32x16 S[4];
#pragma unroll
  for (int i = 0; i < 4; ++i)
#pragma unroll
    for (int e = 0; e < 16; ++e) S[i][e] = 0.f;
  for (int c = 0; c < 64; ++c) {
    const int t0 = c * 64;
    __syncthreads();
    uint4 gv0, gv1, gv2, gv3;
    {
      const size_t tok0 = tokbase + t0;
      float* sLF = (float*)smem;
      u16* sQst = sKT;
      float4 l0, l1, l2, l3, l4, l5, l6, l7;
      {
        const int c4 = tid & 31, r0 = tid >> 5;
        const float* lp = p.blf + (tok0 + r0) * 512 + h * 128 + c4 * 4;
        l0 = *(const float4*)(lp); l1 = *(const float4*)(lp + 8 * 512); l2 = *(const float4*)(lp + 16 * 512);
        l3 = *(const float4*)(lp + 24 * 512); l4 = *(const float4*)(lp + 32 * 512); l5 = *(const float4*)(lp + 40 * 512);
        l6 = *(const float4*)(lp + 48 * 512); l7 = *(const float4*)(lp + 56 * 512);
      }
      uint4 q0, q1, q2, q3;
      {
        const int c8 = tid & 15, r0 = tid >> 4;
        const u16* qp = p.bq + (tok0 + r0) * 512 + h * 128 + c8 * 8;
        q0 = *(const uint4*)(qp); q1 = *(const uint4*)(qp + 16 * 512); q2 = *(const uint4*)(qp + 32 * 512); q3 = *(const uint4*)(qp + 48 * 512);
      }
      const int tt = tid >> 2, v0 = (tid & 3) * 32;
      const u16* vp = p.bi + (tok0 + tt) * 512 + h * 128 + v0;
      uint4 w0 = *(const uint4*)(vp), w1 = *(const uint4*)(vp + 8), w2 = *(const uint4*)(vp + 16), w3 = *(const uint4*)(vp + 24);
      const u16* gp = p.bg + (tok0 + tt) * 512 + h * 128 + v0;
      gv0 = *(const uint4*)(gp); gv1 = *(const uint4*)(gp + 8); gv2 = *(const uint4*)(gp + 16); gv3 = *(const uint4*)(gp + 24);
      {
        const int c4 = tid & 31, r0 = tid >> 5;
        float* sp = sLF + r0 * 128 + c4 * 4;
        *(float4*)(sp) = l0; *(float4*)(sp + 8 * 128) = l1; *(float4*)(sp + 16 * 128) = l2; *(float4*)(sp + 24 * 128) = l3;
        *(float4*)(sp + 32 * 128) = l4; *(float4*)(sp + 40 * 128) = l5; *(float4*)(sp + 48 * 128) = l6; *(float4*)(sp + 56 * 128) = l7;
        const int c8 = tid & 15, r1 = tid >> 4;
        u16* qs = sQst + r1 * 128 + c8 * 8;
        *(uint4*)(qs) = q0; *(uint4*)(qs + 16 * 128) = q1; *(uint4*)(qs + 32 * 128) = q2; *(uint4*)(qs + 48 * 128) = q3;
      }
      {
        u16* vt = sVT + v0 * 72 + tt;
#define VT_PUT(W, e_) { vt[(2 * (e_)) * 72] = (u16)((W) & 0xffffu); vt[(2 * (e_) + 1) * 72] = (u16)((W) >> 16); }
        VT_PUT(w0.x, 0) VT_PUT(w0.y, 1) VT_PUT(w0.z, 2) VT_PUT(w0.w, 3)
        VT_PUT(w1.x, 4) VT_PUT(w1.y, 5) VT_PUT(w1.z, 6) VT_PUT(w1.w, 7)
        VT_PUT(w2.x, 8) VT_PUT(w2.y, 9) VT_PUT(w2.z, 10) VT_PUT(w2.w, 11)
        VT_PUT(w3.x, 12) VT_PUT(w3.y, 13) VT_PUT(w3.z, 14) VT_PUT(w3.w, 15)
#undef VT_PUT
      }
      __syncthreads();
      const int d = tid & 127, half = tid >> 7;
      float lfr[32];
      unsigned short qr[32];
      float tot = 0.f;
#pragma unroll
      for (int i = 0; i < 32; ++i) {
        lfr[i] = sLF[(half * 32 + i) * 128 + d];
        qr[i] = sQst[(half * 32 + i) * 128 + d];
        tot += lfr[i];
      }
      sTot[half * 128 + d] = tot;
      __syncthreads();
      float t0v = sTot[d], t1v = sTot[128 + d];
      float blast = t0v + t1v;
      float run = half ? t0v : 0.f;
      if (half == 0) sDecay[d] = __expf(blast);
      u16* sQw = sQ + (half * 32) * 136 + d;
      u16* sKw = sK + (half * 32) * 136 + d;
      u16* sKTw = sKT + d * 72 + half * 32;
#pragma unroll
      for (int i = 0; i < 32; ++i) {
        float qvi = bf2f(qr[i]);
        float lfi = lfr[i];
        run += lfi;
        float bc = fmaxf(run, -80.f);
        float e = __expf(bc);
        float kf = 1.f - __expf(lfi);
        float qt = qvi * e;
        float kt = kf * __expf(-bc);
        sQw[i * 136] = f2bf(qt);
        u16 kb = f2bf(kt);
        sKw[i * 136] = kb;
        sKTw[i] = kb;
      }
    }
    __syncthreads();
    __builtin_amdgcn_sched_barrier(0);
    f32x16 X00, X01, X11;
#pragma unroll
    for (int e = 0; e < 16; ++e) { X00[e] = 0.f; X01[e] = 0.f; X11[e] = 0.f; }
#pragma unroll
    for (int ks = 0; ks < 8; ++ks) {
      bf16x8 k0 = *(const bf16x8*)(sK + (lr) * 136 + ks * 16 + lh * 8);
      bf16x8 k1 = *(const bf16x8*)(sK + (32 + lr) * 136 + ks * 16 + lh * 8);
      bf16x8 q0 = *(const bf16x8*)(sQ + (lr) * 136 + ks * 16 + lh * 8);
      bf16x8 q1 = *(const bf16x8*)(sQ + (32 + lr) * 136 + ks * 16 + lh * 8);
      X00 = __builtin_amdgcn_mfma_f32_32x32x16_bf16(k0, q0, X00, 0, 0, 0);
      X01 = __builtin_amdgcn_mfma_f32_32x32x16_bf16(k0, q1, X01, 0, 0, 0);
      X11 = __builtin_amdgcn_mfma_f32_32x32x16_bf16(k1, q1, X11, 0, 0, 0);
    }
    {
      const int dl = lr - 4 * lh;
#pragma unroll
      for (int e = 0; e < 16; ++e) {
        if (((e & 3) + 8 * (e >> 2)) > dl) { X00[e] = 0.f; X11[e] = 0.f; }
      }
    }
    __builtin_amdgcn_sched_barrier(0);
    f32x16 O0, O1;
#pragma unroll
    for (int e = 0; e < 16; ++e) { O0[e] = 0.f; O1[e] = 0.f; }
    const u16* vrow = sVT + (wave * 32 + lr) * 72;
#pragma unroll
    for (int s2 = 0; s2 < 2; ++s2) {
      bf16x8 a00, a01, a11;
#pragma unroll
      for (int j = 0; j < 8; ++j) {
        a00[j] = (short)f2bf(X00[8 * s2 + j]);
        a01[j] = (short)f2bf(X01[8 * s2 + j]);
        a11[j] = (short)f2bf(X11[8 * s2 + j]);
      }
      bf16x4 v0a = *(const bf16x4*)(vrow + 0 + 16 * s2 + 4 * lh);
      bf16x4 v0b = *(const bf16x4*)(vrow + 0 + 16 * s2 + 4 * lh + 8);
      bf16x4 v1a = *(const bf16x4*)(vrow + 32 + 16 * s2 + 4 * lh);
      bf16x4 v1b = *(const bf16x4*)(vrow + 32 + 16 * s2 + 4 * lh + 8);
      bf16x8 bv0 = {v0a[0], v0a[1], v0a[2], v0a[3], v0b[0], v0b[1], v0b[2], v0b[3]};
      bf16x8 bv1 = {v1a[0], v1a[1], v1a[2], v1a[3], v1b[0], v1b[1], v1b[2], v1b[3]};
      O0 = __builtin_amdgcn_mfma_f32_32x32x16_bf16(a00, bv0, O0, 0, 0, 0);
      O1 = __builtin_amdgcn_mfma_f32_32x32x16_bf16(a01, bv0, O1, 0, 0, 0);
      O1 = __builtin_amdgcn_mfma_f32_32x32x16_bf16(a11, bv1, O1, 0, 0, 0);
    }
    __builtin_amdgcn_sched_barrier(0);
#ifndef HG_NO_P2
#pragma unroll
    for (int db = 0; db < 4; ++db) {
#pragma unroll
      for (int s2 = 0; s2 < 2; ++s2) {
        bf16x8 bs;
#pragma unroll
        for (int j = 0; j < 8; ++j) bs[j] = (short)f2bf(S[db][8 * s2 + j]);
        const u16* q0p = sQ + (lr) * 136 + db * 32 + 16 * s2 + 4 * lh;
        const u16* q1p = sQ + (32 + lr) * 136 + db * 32 + 16 * s2 + 4 * lh;
        bf16x4 x0a = *(const bf16x4*)(q0p), x0b = *(const bf16x4*)(q0p + 8);
        bf16x4 x1a = *(const bf16x4*)(q1p), x1b = *(const bf16x4*)(q1p + 8);
        bf16x8 aq0 = {x0a[0], x0a[1], x0a[2], x0a[3], x0b[0], x0b[1], x0b[2], x0b[3]};
        bf16x8 aq1 = {x1a[0], x1a[1], x1a[2], x1a[3], x1b[0], x1b[1], x1b[2], x1b[3]};
        O0 = __builtin_amdgcn_mfma_f32_32x32x16_bf16(aq0, bs, O0, 0, 0, 0);
        O1 = __builtin_amdgcn_mfma_f32_32x32x16_bf16(aq1, bs, O1, 0, 0, 0);
      }
      __builtin_amdgcn_sched_barrier(0);
    }
#endif
    __builtin_amdgcn_sched_barrier(0);
#ifndef HG_NO_SU
#pragma unroll
    for (int db = 0; db < 4; ++db) {
#pragma unroll
      for (int ks = 0; ks < 4; ++ks) {
        bf16x8 ak = *(const bf16x8*)(sKT + (db * 32 + lr) * 72 + ks * 16 + lh * 8);
        bf16x8 bv = *(const bf16x8*)(vrow + ks * 16 + lh * 8);
        S[db] = __builtin_amdgcn_mfma_f32_32x32x16_bf16(ak, bv, S[db], 0, 0, 0);
      }
      {
        const float* dcp = sDecay + 4 * lh;
#pragma unroll
        for (int e = 0; e < 16; ++e) S[db][e] *= dcp[db * 32 + (e & 3) + 8 * (e >> 2)];
      }
      __builtin_amdgcn_sched_barrier(0);
    }
#endif
    __syncthreads();
    {
      float* ob = sO + (4 * lh) * 132 + wave * 32 + lr;
#pragma unroll
      for (int e = 0; e < 16; ++e) {
        ob[((e & 3) + 8 * (e >> 2)) * 132] = O0[e];
        ob[(32 + (e & 3) + 8 * (e >> 2)) * 132] = O1[e];
      }
    }
    __syncthreads();
#ifndef HG_NO_NORM
    {
      int tt = tid >> 2, qd = tid & 3;
      float ov[32];
      float ss = 0.f;
#pragma unroll
      for (int i = 0; i < 32; ++i) { ov[i] = sO[tt * 132 + qd * 32 + i]; ss += ov[i] * ov[i]; }
      ss += __shfl_xor(ss, 1);
      ss += __shfl_xor(ss, 2);
      float r = rsqrtf(ss * (1.f / 128.f) + 1e-6f);
      size_t tok = tokbase + t0 + tt;
      u16* op = p.mixin + tok * 1024 + 512 + h * 128 + qd * 32;
      const float* bog = p.b_out_g + qd * 32;
#define HG_OUT(GW, i_) { \
        const int vi = (i_) * 8; \
        unsigned o0_ = pack2(ov[vi + 0] * r * bog[vi + 0] * __uint_as_float(GW.x << 16), ov[vi + 1] * r * bog[vi + 1] * __uint_as_float(GW.x & 0xffff0000u)); \
        unsigned o1_ = pack2(ov[vi + 2] * r * bog[vi + 2] * __uint_as_float(GW.y << 16), ov[vi + 3] * r * bog[vi + 3] * __uint_as_float(GW.y & 0xffff0000u)); \
        unsigned o2_ = pack2(ov[vi + 4] * r * bog[vi + 4] * __uint_as_float(GW.z << 16), ov[vi + 5] * r * bog[vi + 5] * __uint_as_float(GW.z & 0xffff0000u)); \
        unsigned o3_ = pack2(ov[vi + 6] * r * bog[vi + 6] * __uint_as_float(GW.w << 16), ov[vi + 7] * r * bog[vi + 7] * __uint_as_float(GW.w & 0xffff0000u)); \
        *(uint4*)(op + vi) = make_uint4(o0_, o1_, o2_, o3_); }
      HG_OUT(gv0, 0) HG_OUT(gv1, 1) HG_OUT(gv2, 2) HG_OUT(gv3, 3)
#undef HG_OUT
    }
#endif
  }
}

__device__ void mixer0_phase(const Params& p, char* smem, int coff, int sub) {
  int* s_item = (int*)(smem + SMEM_BYTES - 16);
#ifndef NO_HGRN
#ifndef REPEAT_HGRN
#define REPEAT_HGRN 0
#endif
  if (sub & 1)
  for (;;) {
    int item = next_item(p.ctr + coff + 0, s_item);
    if (item >= 32) break;
    hgrn_item(p, item >> 2, item & 3, smem);
  }
#endif
#ifndef NO_DSA
#ifndef REPEAT_DSA
#define REPEAT_DSA 0
#endif
  if (sub & 2) {
    const int b = blockIdx.x & 7;
    int di = next_item(p.ctr + coff + 8 + b, s_item);
    while (di < 512) {
      unsigned nxt = 0u;
      if (threadIdx.x == 0) nxt = atomicAdd(p.ctr + coff + 8 + b, 1u);
      dsa_item(p, b, (511 - di) * 8, smem, sub);
      __syncthreads();
      if (threadIdx.x == 0) *s_item = (int)nxt;
      __syncthreads();
      di = *s_item;
    }
  }
#endif
}

__device__ __forceinline__ void swa_item(const Params& p, int b, int g, int qblk, char* smem) {
  u16* sVT = (u16*)smem;
  const int tid = threadIdx.x, lane = tid & 63, wave = __builtin_amdgcn_readfirstlane(tid >> 6);
  const int lr = lane & 31, lh = lane >> 5;
  const size_t tokbase = (size_t)b * SEQ;
  const int t0 = qblk * 32, kbase = t0 - 128;
  const int h = 4 * g + wave;
  __syncthreads();
#pragma unroll
  for (int i = 0; i < 5; ++i) {
    int cidx = tid + 256 * i;
    int key = cidx >> 3, dc = (cidx & 7) * 8;
    int j = kbase + key; j = j < 0 ? 0 : j;
    uint4 w = *(const uint4*)(p.dkv + (tokbase + j) * 256 + 128 + g * 64 + dc);
    unsigned ww[4] = {w.x, w.y, w.z, w.w};
    u16* dst = sVT + dc * 168 + key;
#pragma unroll
    for (int e = 0; e < 4; ++e) {
      dst[(2 * e) * 168] = (u16)(ww[e] & 0xffffu);
      dst[(2 * e + 1) * 168] = (u16)(ww[e] >> 16);
    }
  }
  bf16x8 qf[4];
  {
    const u16* qp = p.dq + (tokbase + t0 + lr) * 512 + h * 64 + 8 * lh;
#pragma unroll
    for (int ks = 0; ks < 4; ++ks) qf[ks] = *(const bf16x8*)(qp + ks * 16);
  }
  f32x16 S0, S1, S2, S3, S4;
#define SWA_QK(ST, kt_) { \
    int j = kbase + (kt_) * 32 + lr; j = j < 0 ? 0 : j; \
    const u16* kp = p.dkv + (tokbase + j) * 256 + g * 64 + 8 * lh; \
    bf16x8 k0 = *(const bf16x8*)(kp), k1 = *(const bf16x8*)(kp + 16), k2 = *(const bf16x8*)(kp + 32), k3 = *(const bf16x8*)(kp + 48); \
    _Pragma("unroll") for (int e = 0; e < 16; ++e) ST[e] = 0.f; \
    ST = __builtin_amdgcn_mfma_f32_32x32x16_bf16(k0, qf[0], ST, 0, 0, 0); \
    ST = __builtin_amdgcn_mfma_f32_32x32x16_bf16(k1, qf[1], ST, 0, 0, 0); \
    ST = __builtin_amdgcn_mfma_f32_32x32x16_bf16(k2, qf[2], ST, 0, 0, 0); \
    ST = __builtin_amdgcn_mfma_f32_32x32x16_bf16(k3, qf[3], ST, 0, 0, 0); }
  SWA_QK(S0, 0) SWA_QK(S1, 1) SWA_QK(S2, 2) SWA_QK(S3, 3) SWA_QK(S4, 4)
#undef SWA_QK
  const int tq = t0 + lr;
  float m = -INFINITY;
#define SWA_MASK(ST, kt_) { _Pragma("unroll") for (int e = 0; e < 16; ++e) { \
    int j = kbase + (kt_) * 32 + (e & 3) + 8 * (e >> 2) + 4 * lh; \
    bool ok = (j >= 0) && (j <= tq) && (j > tq - 128); \
    float v = ok ? ST[e] : -INFINITY; ST[e] = v; m = fmaxf(m, v); } }
  SWA_MASK(S0, 0) SWA_MASK(S1, 1) SWA_MASK(S2, 2) SWA_MASK(S3, 3) SWA_MASK(S4, 4)
#undef SWA_MASK
  m = fmaxf(m, __shfl_xor(m, 32));
  const float sk = p.d_sinks[h];
  m = fmaxf(m, sk);
  float sum = 0.f;
#define SWA_EXP(ST) { _Pragma("unroll") for (int e = 0; e < 16; ++e) { float pv = __expf(ST[e] - m); ST[e] = pv; sum += pv; } }
  SWA_EXP(S0) SWA_EXP(S1) SWA_EXP(S2) SWA_EXP(S3) SWA_EXP(S4)
#undef SWA_EXP
  sum += __shfl_xor(sum, 32);
  sum += __expf(sk - m);
  const float inv = 1.f / sum;
  __syncthreads();
  f32x16 O0, O1;
#pragma unroll
  for (int e = 0; e < 16; ++e) { O0[e] = 0.f; O1[e] = 0.f; }
#define SWA_PV(ST, kt_) { _Pragma("unroll") for (int s2 = 0; s2 < 2; ++s2) { \
    bf16x8 pb; \
    _Pragma("unroll") for (int j = 0; j < 8; ++j) pb[j] = (short)f2bf(ST[8 * s2 + j]); \
    const u16* v0p = sVT + lr * 168 + (kt_) * 32 + 16 * s2 + 4 * lh; \
    const u16* v1p = v0p + 32 * 168; \
    bf16x4 a0a = *(const bf16x4*)(v0p), a0b = *(const bf16x4*)(v0p + 8); \
    bf16x4 a1a = *(const bf16x4*)(v1p), a1b = *(const bf16x4*)(v1p + 8); \
    bf16x8 va0 = {a0a[0], a0a[1], a0a[2], a0a[3], a0b[0], a0b[1], a0b[2], a0b[3]}; \
    bf16x8 va1 = {a1a[0], a1a[1], a1a[2], a1a[3], a1b[0], a1b[1], a1b[2], a1b[3]}; \
    O0 = __builtin_amdgcn_mfma_f32_32x32x16_bf16(va0, pb, O0, 0, 0, 0); \
    O1 = __builtin_amdgcn_mfma_f32_32x32x16_bf16(va1, pb, O1, 0, 0, 0); } }
  SWA_PV(S0, 0) SWA_PV(S1, 1) SWA_PV(S2, 2) SWA_PV(S3, 3) SWA_PV(S4, 4)
#undef SWA_PV
  u16* op = p.mixin + (tokbase + tq) * 1024 + 512 + h * 64 + 4 * lh;
#pragma unroll
  for (int i = 0; i < 4; ++i) {
    *(uint2*)(op + 8 * i) = make_uint2(pack2(O0[4 * i] * inv, O0[4 * i + 1] * inv), pack2(O0[4 * i + 2] * inv, O0[4 * i + 3] * inv));
    *(uint2*)(op + 32 + 8 * i) = make_uint2(pack2(O1[4 * i] * inv, O1[4 * i + 1] * inv), pack2(O1[4 * i + 2] * inv, O1[4 * i + 3] * inv));
  }
}

__device__ void griffin_item(const Params& p, int b, int nb, int qq, char* smem) {
  float* sWr = (float*)smem;
  float* sWi = sWr + 1040;
  float* sCW = sWi + 1040;
  float* sCB = sCW + 256;
  float* sCst = sCB + 64;
  float* sAa = sCst + 48;
  float* sUu = sAa + 64 * 17;
  float* sSumA = sUu + 64 * 17;
  float* sSumH = sSumA + 256;
  float* sCarry = sSumH + 256;
  float* sG = sCarry + 16;
  float* sXo = sG + 64 * 33;
  u16* sXb = (u16*)(sXo + 64 * 17 + 4);
  const int tid = threadIdx.x, lane = tid & 63;
  const int wave = __builtin_amdgcn_readfirstlane(tid >> 6);
  const int lr = lane & 31, lh = lane >> 5;
  const int cgp = tid & 3, tl = tid >> 2;
  const size_t tokbase = (size_t)b * SEQ;
  const int cbase = nb * 64;
  const int obase = cbase + qq * 16;
  __syncthreads();
  sCW[tid] = p.c_conv_w[(tid >> 6) * 512 + cbase + (tid & 63)];
  if (tid < 64) sCB[tid] = p.c_conv_b[cbase + tid];
  if (tid < 16) {
    sCarry[tid] = 0.f;
    sCst[tid] = p.c_rg_b[obase + tid]; sCst[16 + tid] = p.c_ig_b[obase + tid];
    sCst[32 + tid] = log1pf(__expf(-p.c_lam[obase + tid]));
  }
  __syncthreads();
  u16* sWb = sXb + 64 * 72;
  {
    const int col = tid >> 3, ci0 = (tid & 7) * 8;
    const float* wsrc = ((col < 16) ? (p.c_rg_w + qq * 16 + col) : (p.c_ig_w + qq * 16 + (col - 16))) + (size_t)nb * 4096 + ci0 * 64;
    float w8[8];
#pragma unroll
    for (int j = 0; j < 8; ++j) w8[j] = wsrc[j * 64];
    *(uint4*)(sWb + col * 72 + ci0) = make_uint4(pack2(w8[0], w8[1]), pack2(w8[2], w8[3]), pack2(w8[4], w8[5]), pack2(w8[6], w8[7]));
  }
  __syncthreads();
  const int c = tid & 15, seg = tid >> 4;
  const float* cxp = p.cx + tokbase * 512 + cbase + cgp * 16;
  float4 nx[16];
#pragma unroll
  for (int i = 0; i < 16; ++i) nx[i] = make_float4(0.f, 0.f, 0.f, 0.f);
  for (int tile = -1; tile < 64; ++tile) {
    u16 ccg[4];
    if (tile >= 0) {
      int sg0 = seg, c0_ = c;
      asm volatile("" : "+v"(sg0), "+v"(c0_));
      const u16* cgt0 = p.cg + (tokbase + tile * 64 + sg0 * 4) * 512 + obase + c0_;
#pragma unroll
      for (int i = 0; i < 4; ++i) ccg[i] = cgt0[i * 512];
    } else {
#pragma unroll
      for (int i = 0; i < 4; ++i) ccg[i] = 0;
    }
    f32x16 xc;
#pragma unroll
    for (int j = 0; j < 4; ++j) {
      float4 acc4 = *(const float4*)(sCB + cgp * 16 + j * 4);
#pragma unroll
      for (int w = 0; w < 4; ++w) {
        float4 wv = *(const float4*)(sCW + w * 64 + cgp * 16 + j * 4);
        float4 xv = nx[w * 4 + j];
        acc4.x += xv.x * wv.x; acc4.y += xv.y * wv.y; acc4.z += xv.z * wv.z; acc4.w += xv.w * wv.w;
      }
      xc[j * 4] = acc4.x; xc[j * 4 + 1] = acc4.y; xc[j * 4 + 2] = acc4.z; xc[j * 4 + 3] = acc4.w;
    }
    __builtin_amdgcn_sched_barrier(0);
    if (tile + 1 < 64) {
      int tlo = tl, sgo = seg;
      asm volatile("" : "+v"(tlo), "+v"(sgo));
      const float* cpt = cxp + (size_t)((tile + 1) * 64 + tlo - 3) * 512;
      const bool first = (tile + 1 == 0);
#pragma unroll
      for (int w = 0; w < 4; ++w) {
        const bool ok = !first || (tlo - 3 + w >= 0);
#pragma unroll
        for (int j = 0; j < 4; ++j) nx[w * 4 + j] = ok ? *(const float4*)(cpt + w * 512 + j * 4) : make_float4(0.f, 0.f, 0.f, 0.f);
      }

    }
    __builtin_amdgcn_sched_barrier(0);
    if (tile < 0) continue;
    int tlv = tl, cgv = cgp;
    asm volatile("" : "+v"(tlv), "+v"(cgv));
    {
      u16* xb = sXb + tlv * 72 + cgv * 16;
      *(uint4*)(xb) = make_uint4(pack2(xc[0], xc[1]), pack2(xc[2], xc[3]), pack2(xc[4], xc[5]), pack2(xc[6], xc[7]));
      *(uint4*)(xb + 8) = make_uint4(pack2(xc[8], xc[9]), pack2(xc[10], xc[11]), pack2(xc[12], xc[13]), pack2(xc[14], xc[15]));
      if (cgp == qq) {
#pragma unroll
        for (int k = 0; k < 16; ++k) sXo[tlv * 17 + k] = xc[k];
      }
    }
    asm volatile("s_waitcnt lgkmcnt(0)" ::: "memory");
    {
      const int l15 = lane & 15, l4 = lane >> 4;
      const u16* ab = sXb + (wave * 16 + l15) * 72 + 8 * l4;
      const u16* wb = sWb + l15 * 72 + 8 * l4;
      f32x4 g0 = {0.f, 0.f, 0.f, 0.f}, g1 = {0.f, 0.f, 0.f, 0.f};
#pragma unroll
      for (int ks = 0; ks < 2; ++ks) {
        bf16x8 a = *(const bf16x8*)(ab + ks * 32);
        bf16x8 b0 = *(const bf16x8*)(wb + ks * 32);
        bf16x8 b1 = *(const bf16x8*)(wb + 16 * 72 + ks * 32);
        g0 = __builtin_amdgcn_mfma_f32_16x16x32_bf16(a, b0, g0, 0, 0, 0);
        g1 = __builtin_amdgcn_mfma_f32_16x16x32_bf16(a, b1, g1, 0, 0, 0);
      }
      float* gb = sG + (wave * 16 + 4 * l4) * 33 + l15;
#pragma unroll
      for (int j = 0; j < 4; ++j) { gb[j * 33] = g0[j]; gb[j * 33 + 16] = g1[j]; }
    }
    asm volatile("s_waitcnt lgkmcnt(0)" ::: "memory");
#pragma unroll
    for (int k = 0; k < 4; ++k) {
      int cc = cgv * 4 + k;
      float rp = sG[tlv * 33 + cc] + sCst[cc];
      float ip = sG[tlv * 33 + 16 + cc] + sCst[16 + cc];
      float r = __builtin_amdgcn_rcpf(1.f + __expf(-rp));
      float ig = __builtin_amdgcn_rcpf(1.f + __expf(-ip));
      float la = -8.f * r * sCst[32 + cc];
      float a = __expf(la);
      float u = __builtin_amdgcn_sqrtf(fmaxf(1.f - a * a, 0.f)) * (ig * sXo[tlv * 17 + cc]);
      sAa[tlv * 17 + cc] = a;
      sUu[tlv * 17 + cc] = u;
    }
    __syncthreads();
    float av[4], uv[4];
    {
      float A = 1.f, H = 0.f;
#pragma unroll
      for (int i = 0; i < 4; ++i) {
        av[i] = sAa[(seg * 4 + i) * 17 + c]; uv[i] = sUu[(seg * 4 + i) * 17 + c];
        H = av[i] * H + uv[i]; A *= av[i];
      }
      sSumA[seg * 16 + c] = A; sSumH[seg * 16 + c] = H;
    }
    __syncthreads();
    float hcur = sCarry[c];
    for (int s2 = 0; s2 < seg; ++s2) hcur = sSumA[s2 * 16 + c] * hcur + sSumH[s2 * 16 + c];
    __syncthreads();
    {
      int sg2 = seg, c2 = c;
      asm volatile("" : "+v"(sg2), "+v"(c2));
      u16* mo = p.mixin + (tokbase + tile * 64 + sg2 * 4) * 1024 + obase + c2;
#pragma unroll
      for (int i = 0; i < 4; ++i) {
        hcur = av[i] * hcur + uv[i];
        mo[i * 1024] = f2bf(bf2f(ccg[i]) * hcur);
      }
    }
    if (seg == 15) sCarry[c] = hcur;
  }
}

__device__ void mixer1_phase(const Params& p, char* smem, int coff, int sub) {
  int* s_item = (int*)(smem + SMEM_BYTES - 16);
  const int wave = __builtin_amdgcn_readfirstlane(threadIdx.x >> 6);
#ifndef NO_GRIFFIN
  if (sub & 1)
  for (;;) {
    int item = next_item(p.ctr + coff + 1, s_item);
    if (item >= 256) break;
    griffin_item(p, item >> 5, (item >> 2) & 7, item & 3, smem);
  }
#endif
#ifndef NO_SWA
  if (sub & 2) {
    const int b = blockIdx.x & 7;
    const size_t tokbase = (size_t)b * SEQ;
    int si = next_item(p.ctr + coff + 16 + b, s_item);
    while (si < 256) {
      unsigned nxt = 0u;
      if (threadIdx.x == 0) nxt = atomicAdd(p.ctr + coff + 16 + b, 1u);
      swa_item(p, b, si & 1, si >> 1, smem);
      __syncthreads();
      if (threadIdx.x == 0) *s_item = (int)nxt;
      __syncthreads();
      si = *s_item;
    }
  }
#endif
}

__device__ __forceinline__ void carve_ws(Params& p) {
  char* w = p.ws;
  size_t off = 0;
  auto take = [&](size_t bytes) { char* r = w + off; off += (bytes + 255) & ~(size_t)255; return r; };
  p.wt_in0 = (u16*)take((size_t)N_IN0 * 1024 * 2);
  p.wt_out0 = (u16*)take((size_t)1024 * 1024 * 2);
  p.wt_up0 = (u16*)take((size_t)4096 * 1024 * 2);
  p.wt_dn0 = (u16*)take((size_t)4096 * 1024 * 2);
  p.wt_in1 = (u16*)take((size_t)N_IN1 * 1024 * 2);
  p.wt_out1 = (u16*)take((size_t)1024 * 1024 * 2);
  p.wt_up1 = (u16*)take((size_t)4096 * 1024 * 2);
  p.wt_dn1 = (u16*)take((size_t)4096 * 1024 * 2);
  p.abuf = (u16*)take((size_t)T_TOK * 1024 * 2);
  p.mixin = (u16*)take((size_t)T_TOK * 1024 * 2);
  p.ss = (float*)take((size_t)4 * T_TOK * 4);
  p.rope = (float2*)take((size_t)T_TOK * 32 * 8);
  p.ctr = (unsigned*)take(256);
  char* big = take((size_t)T_TOK * 4096 * 2);
  p.hid = (u16*)big;
  {
    size_t o2 = 0;
    auto take2 = [&](size_t bytes) { char* r = big + o2; o2 += (bytes + 255) & ~(size_t)255; return r; };
    p.aq = (u16*)take2((size_t)T_TOK * 512 * 2);
    p.kv0 = (u16*)take2((size_t)T_TOK * 256 * 2);
    p.iq = (u16*)take2((size_t)T_TOK * 512 * 2);
    p.ik = (u16*)take2((size_t)T_TOK * 64 * 2);
    p.iw = (float*)take2((size_t)T_TOK * 8 * 4);
    p.bq = (u16*)take2((size_t)T_TOK * 512 * 2);
    p.blf = (float*)take2((size_t)T_TOK * 512 * 4);
    p.bi = (u16*)take2((size_t)T_TOK * 512 * 2);
    p.bg = (u16*)take2((size_t)T_TOK * 512 * 2);
  }
  {
    size_t o2 = 0;
    auto take2 = [&](size_t bytes) { char* r = big + o2; o2 += (bytes + 255) & ~(size_t)255; return r; };
    p.cg = (u16*)take2((size_t)T_TOK * 512 * 2);
    p.cx = (float*)take2((size_t)T_TOK * 512 * 4);
    p.dq = (u16*)take2((size_t)T_TOK * 512 * 2);
    p.dkv = (u16*)take2((size_t)T_TOK * 256 * 2);
  }
}

__global__ void __launch_bounds__(256, 2) mega_kernel(Params pin, int ph_lo, int ph_hi, int sub) {
  Params p = pin;
  carve_ws(p);
  __shared__ __attribute__((aligned(16))) char smem[SMEM_BYTES];
  GemmArgs ga;
#define PHASE_BEGIN(n) if (((PHASE_MASK >> n) & 1) && ph_lo <= n && n <= ph_hi) { if (n > ph_lo) cg::this_grid().sync();
#define PHASE_END }
  PHASE_BEGIN(0) for (int rep = 0; rep < 1 + (REPEAT_MASK & 1); ++rep) { if (rep) cg::this_grid().sync(); prep_phase(p, smem); } PHASE_END
  PHASE_BEGIN(1)
    ga = GemmArgs{p.abuf, p.wt_in0, 1024, N_IN0 / 128, p.ss, nullptr, nullptr, nullptr, nullptr, nullptr};
    for (int rep = 0; rep < 1 + ((REPEAT_MASK >> 1) & 1); ++rep) { if (rep) cg::this_grid().sync(); gemm_phase<EPI_IN0>(p, ga, smem); }
  PHASE_END
  PHASE_BEGIN(2) for (int rep = 0; rep < 1 + ((REPEAT_MASK >> 2) & 1); ++rep) { if (rep) cg::this_grid().sync(); mixer0_phase(p, smem, rep * 4, sub); } PHASE_END
  PHASE_BEGIN(3)
    ga = GemmArgs{p.mixin, p.wt_out0, 1024, 8, nullptr, p.x, p.out, p.norm_mlp_g, p.ss + T_TOK, p.abuf};
    gemm_phase<EPI_RES>(p, ga, smem);
  PHASE_END
  PHASE_BEGIN(4)
    ga = GemmArgs{p.abuf, p.wt_up0, 1024, 32, p.ss + T_TOK, nullptr, nullptr, nullptr, nullptr, nullptr};
    for (int rep = 0; rep < 1 + ((REPEAT_MASK >> 4) & 1); ++rep) { if (rep) cg::this_grid().sync(); gemm_phase<EPI_UP>(p, ga, smem); }
  PHASE_END
  PHASE_BEGIN(5)
    ga = GemmArgs{p.hid, p.wt_dn0, 4096, 8, nullptr, p.out, p.out, p.norm_mix_g + 1024, p.ss + 2 * T_TOK, p.abuf};
    gemm_phase<EPI_RES>(p, ga, smem);
  PHASE_END
  PHASE_BEGIN(6)
    ga = GemmArgs{p.abuf, p.wt_in1, 1024, N_IN1 / 128, p.ss + 2 * T_TOK, nullptr, nullptr, nullptr, nullptr, nullptr};
    gemm_phase<EPI_IN1>(p, ga, smem);
  PHASE_END
  PHASE_BEGIN(7) for (int rep = 0; rep < 1 + ((REPEAT_MASK >> 7) & 1); ++rep) { if (rep) cg::this_grid().sync(); mixer1_phase(p, smem, rep * 4, sub); } PHASE_END
  PHASE_BEGIN(8)
    ga = GemmArgs{p.mixin, p.wt_out1, 1024, 8, nullptr, p.out, p.out, p.norm_mlp_g + 1024, p.ss + 3 * T_TOK, p.abuf};
    gemm_phase<EPI_RES>(p, ga, smem);
  PHASE_END
  PHASE_BEGIN(9)
    ga = GemmArgs{p.abuf, p.wt_up1, 1024, 32, p.ss + 3 * T_TOK, nullptr, nullptr, nullptr, nullptr, nullptr};
    gemm_phase<EPI_UP>(p, ga, smem);
  PHASE_END
  PHASE_BEGIN(10)
    ga = GemmArgs{p.hid, p.wt_dn1, 4096, 8, nullptr, p.out, p.out, nullptr, nullptr, nullptr};
    gemm_phase<EPI_RES>(p, ga, smem);
  PHASE_END
}

extern "C" void kernel_launch(void* const* d_in, const int* in_sizes, int n_in, void* d_out, int out_size, void* d_ws,
                              size_t ws_size, hipStream_t stream) {
  Params p{};
  p.x = (const float*)d_in[0]; p.pos = (const int*)d_in[1];
  p.norm_mix_g = (const float*)d_in[2]; p.norm_mlp_g = (const float*)d_in[3];
  p.even_w_in = (const float*)d_in[4]; p.even_w_out = (const float*)d_in[5];
  p.a_q_g = (const float*)d_in[6]; p.a_k_g = (const float*)d_in[7];
  p.b_lb = (const float*)d_in[8]; p.b_out_g = (const float*)d_in[9];
  p.odd_w_in = (const float*)d_in[10]; p.odd_w_out = (const float*)d_in[11];
  p.c_conv_w = (const float*)d_in[12]; p.c_conv_b = (const float*)d_in[13];
  p.c_rg_w = (const float*)d_in[14]; p.c_rg_b = (const float*)d_in[15];
  p.c_ig_w = (const float*)d_in[16]; p.c_ig_b = (const float*)d_in[17];
  p.c_lam = (const float*)d_in[18]; p.d_q_g = (const float*)d_in[19]; p.d_k_g = (const float*)d_in[20];
  p.d_sinks = (const float*)d_in[21]; p.mlp_up = (const float*)d_in[22]; p.mlp_dn = (const float*)d_in[23];
  p.out = (float*)d_out;
  p.ws = (char*)d_ws;
  static int grid_blocks = 0;
  if (!grid_blocks) {
    int dev = 0, cus = 0, per_cu = 0;
    hipGetDevice(&dev);
    hipDeviceGetAttribute(&cus, hipDeviceAttributeMultiprocessorCount, dev);
    hipOccupancyMaxActiveBlocksPerMultiprocessor(&per_cu, mega_kernel, 256, 0);
    if (per_cu < 1) per_cu = 1;
    if (per_cu > 2) per_cu = 2;
    grid_blocks = cus * per_cu;
  }
#if MULTI_LAUNCH
  for (int ph = 0; ph < NPHASE; ++ph) {
    hipLaunchKernelGGL(mega_kernel, dim3(grid_blocks), dim3(256), 0, stream, p, ph, ph, 3);
  }
#else
  int lo = 0, hi = NPHASE - 1, sub3 = 3;
  void* args[] = {&p, &lo, &hi, &sub3};
  hipError_t e = hipLaunchCooperativeKernel((void*)mega_kernel, dim3(grid_blocks), dim3(256), args, 0, stream);
  if (e != hipSuccess) fprintf(stderr, "cooperative launch failed: %s (grid %d)\n", hipGetErrorString(e), grid_blocks);
  if (PROBE_PHASE >= 0) {
    int l2 = 0, h2 = 0;
    void* a2[] = {&p, &l2, &h2, &sub3};
    (void)hipLaunchCooperativeKernel((void*)mega_kernel, dim3(grid_blocks), dim3(256), a2, 0, stream);
    int l3 = PROBE_PHASE, h3 = PROBE_PHASE;
    int subp = PROBE_SUB;
    void* a3[] = {&p, &l3, &h3, &subp};
    if (PROBE_PHASE > 0) (void)hipLaunchCooperativeKernel((void*)mega_kernel, dim3(grid_blocks), dim3(256), a3, 0, stream);
  }
#endif
}
```
